# Optimizing an MI355X kernel written in HIP

```python
import math
import jax, jax.numpy as jnp
from jax import lax
import numpy as np

D_MODEL = 1024
BATCH = 8
SEQ = 2048
DEPTH = 4
DEC_BATCH = 128
DEC_SEQ = 1
PAST_LEN = 16384
PAGE_SIZE = 128

CONF_CH = D_MODEL // 2
CONF_KW = 31
N_HEADS = 4
HEAD_K = 128
HEAD_V = 128
QK_DIM = N_HEADS * HEAD_K
V_DIM = N_HEADS * HEAD_V
QKV_DIM = 2 * QK_DIM + V_DIM
SHORT_KW = 4
CHUNK = 64
D_FF = -(-(8 * D_MODEL) // (3 * 256)) * 256
RMS_EPS = 1e-6
LN_EPS = 1e-5
O_GLU_A = CONF_CH
O_GLU_B = 2 * CONF_CH
O_QKV = O_GLU_B + QKV_DIM
O_Z = O_QKV + V_DIM
O_BETA = O_Z + N_HEADS
O_ALPHA = O_BETA + N_HEADS
O_MERGE_A = O_ALPHA + D_MODEL
IN_DIM = O_MERGE_A + D_MODEL

kernel_name = "hybrid_conformer_gdn_adaln_step"


def rms_norm(x, g, eps=RMS_EPS):
    xf = x.astype(jnp.float32)
    y = xf * lax.rsqrt(jnp.mean(xf * xf, axis=-1, keepdims=True) + eps)
    return (y * g.astype(jnp.float32)).astype(x.dtype)


def layer_norm(x, g, b, eps=LN_EPS):
    xf = x.astype(jnp.float32)
    mu = jnp.mean(xf, axis=-1, keepdims=True)
    var = jnp.mean(jnp.square(xf - mu), axis=-1, keepdims=True)
    y = (xf - mu) * lax.rsqrt(var + eps)
    return (y * g.astype(jnp.float32) + b.astype(jnp.float32)).astype(x.dtype)


def l2_normalize(x, eps=1e-6):
    return x * lax.rsqrt(jnp.sum(x * x, axis=-1, keepdims=True) + eps)


def causal_depthwise_conv(x, buf, w):
    width = w.shape[0]
    xp = jnp.concatenate([buf.astype(x.dtype), x], axis=1)
    y = lax.conv_general_dilated(xp, w[:, None, :].astype(x.dtype), window_strides=(1,), padding="VALID",
                                 dimension_numbers=("NWC", "WIO", "NWC"), feature_group_count=x.shape[-1])
    return y, xp[:, xp.shape[1] - (width - 1):]


def gated_delta_rule(q, k, v, beta, g, s0):
    bsz, t_len = q.shape[0], q.shape[1]
    c = min(CHUNK, t_len)
    n_chunks = -(-t_len // c)
    pad = n_chunks * c - t_len

    def prep(a):
        a = a.astype(jnp.float32)
        a = jnp.pad(a, [(0, 0), (0, pad)] + [(0, 0)] * (a.ndim - 2))
        a = a.reshape((bsz, n_chunks, c) + a.shape[2:])
        perm = (1, 0, 3, 2) + tuple(range(4, a.ndim))
        return jnp.transpose(a, perm)

    qc, kc, vc, bc, gc = prep(q), prep(k), prep(v), prep(beta), prep(g)
    gc = jnp.cumsum(gc, axis=-1)
    causal = jnp.tril(jnp.ones((c, c), dtype=bool))
    strict = jnp.tril(jnp.ones((c, c), dtype=bool), k=-1)
    eye = jnp.eye(c, dtype=jnp.float32)

    def step(state, inp):
        q_i, k_i, v_i, b_i, g_i = inp
        diff = g_i[..., :, None] - g_i[..., None, :]
        decay = jnp.where(causal, jnp.exp(jnp.where(causal, diff, 0.0)), 0.0)
        kb = k_i * b_i[..., None]
        kk = jnp.einsum("bhik,bhjk->bhij", kb, k_i)
        a_mat = eye + jnp.where(strict, kk * decay, 0.0)
        rhs = jnp.concatenate([v_i * b_i[..., None], kb * jnp.exp(g_i)[..., None]], axis=-1)
        sol = lax.linalg.triangular_solve(a_mat, rhs, left_side=True, lower=True, unit_diagonal=True)
        u, w = sol[..., :HEAD_V], sol[..., HEAD_V:]
        v_new = u - jnp.einsum("bhck,bhkv->bhcv", w, state)
        qk = jnp.einsum("bhik,bhjk->bhij", q_i, k_i) * decay
        o = (jnp.einsum("bhck,bhkv->bhcv", q_i * jnp.exp(g_i)[..., None], state)
             + jnp.einsum("bhij,bhjv->bhiv", qk, v_new))
        g_last = g_i[..., -1]
        k_dec = k_i * jnp.exp(g_last[..., None] - g_i)[..., None]
        state = state * jnp.exp(g_last)[..., None, None] + jnp.einsum("bhck,bhcv->bhkv", k_dec, v_new)
        return state, o

    s_final, o = lax.scan(step, s0.astype(jnp.float32), (qc, kc, vc, bc, gc))
    o = jnp.transpose(o, (1, 0, 3, 2, 4)).reshape(bsz, n_chunks * c, N_HEADS, HEAD_V)[:, :t_len]
    return o, s_final


def hybrid_layer(x, c, conf_buf, short_buf, s0, w_ada, b_ada, norm1_g, w_in, conf_dw_w, conf_dw_b,
                 conf_ln_g, conf_ln_b, w_conf_out, short_conv_w, a_log, dt_bias, delta_norm_g,
                 w_delta_out, w_merge_out, norm2_g, w_ffn_in, w_ffn_out):
    bsz, t_len, _ = x.shape
    mod = (jax.nn.silu(c) @ w_ada + b_ada)[:, None, :]
    sh1, sc1, gt1, sh2, sc2, gt2 = jnp.split(mod, 6, axis=-1)
    h = rms_norm(x, norm1_g) * (1 + sc1) + sh1
    proj = h @ w_in
    glu_a, glu_b, qkv, z, b_raw, a_raw, m_a, m_b = jnp.split(
        proj, [O_GLU_A, O_GLU_B, O_QKV, O_Z, O_BETA, O_ALPHA, O_MERGE_A], axis=-1)
    u = glu_a * jax.nn.sigmoid(glu_b)
    ca, conf_buf_new = causal_depthwise_conv(u, conf_buf, conf_dw_w)
    ca = jax.nn.silu(layer_norm(ca + conf_dw_b, conf_ln_g, conf_ln_b))
    y_a = ca @ w_conf_out
    qkv_c, short_buf_new = causal_depthwise_conv(qkv, short_buf, short_conv_w)
    qkv_c = jax.nn.silu(qkv_c).astype(jnp.float32)
    q, k, v = jnp.split(qkv_c, [QK_DIM, 2 * QK_DIM], axis=-1)
    q = l2_normalize(q.reshape(bsz, t_len, N_HEADS, HEAD_K)) * (HEAD_K ** -0.5)
    k = l2_normalize(k.reshape(bsz, t_len, N_HEADS, HEAD_K))
    v = v.reshape(bsz, t_len, N_HEADS, HEAD_V)
    beta = jax.nn.sigmoid(b_raw.astype(jnp.float32))
    g = -jnp.exp(a_log.astype(jnp.float32)) * jax.nn.softplus(a_raw.astype(jnp.float32) + dt_bias.astype(jnp.float32))
    o, s_new = gated_delta_rule(q, k, v, beta, g, s0)
    zf = z.astype(jnp.float32).reshape(bsz, t_len, N_HEADS, HEAD_V)
    o = (o * lax.rsqrt(jnp.mean(o * o, axis=-1, keepdims=True) + RMS_EPS)
         * delta_norm_g.astype(jnp.float32) * jax.nn.silu(zf))
    y_b = o.reshape(bsz, t_len, V_DIM).astype(x.dtype) @ w_delta_out
    merged = jax.nn.sigmoid(m_a) * y_a + jax.nn.sigmoid(m_b) * y_b
    x = x + gt1 * (merged @ w_merge_out)
    h2 = rms_norm(x, norm2_g) * (1 + sc2) + sh2
    gate, up = jnp.split(h2 @ w_ffn_in, 2, axis=-1)
    x = x + gt2 * ((jax.nn.silu(gate) * up) @ w_ffn_out)
    return x, conf_buf_new, short_buf_new, s_new


def setup_inputs(seed: int = 0) -> dict:
    key = jax.random.key(seed)
    ks = jax.random.split(key, 32)
    D = D_MODEL

    def nrm(k, shape, scale):
        return jax.random.normal(k, shape, jnp.float32) * scale

    dt = jnp.exp(jax.random.uniform(ks[17], (DEPTH, N_HEADS), jnp.float32, math.log(1e-3), math.log(1e-1)))
    return {
        "x_prompt": nrm(ks[0], (BATCH, SEQ, D), 1.0),
        "x_sample": nrm(ks[1], (DEC_BATCH, DEC_SEQ, D), 1.0),
        "c_prompt": nrm(ks[2], (BATCH, D), 1.0),
        "c_sample": nrm(ks[3], (DEC_BATCH, D), 1.0),
        "state_conformer_conv": nrm(ks[4], (DEPTH, DEC_BATCH, CONF_KW - 1, CONF_CH), 0.5),
        "state_short_conv": nrm(ks[5], (DEPTH, DEC_BATCH, SHORT_KW - 1, QKV_DIM), 1.0),
        "state_delta": nrm(ks[6], (DEPTH, DEC_BATCH, N_HEADS, HEAD_K, HEAD_V), 0.05),
        "w_ada": nrm(ks[7], (DEPTH, D, 6 * D), 0.5 * D ** -0.5),
        "b_ada": nrm(ks[8], (DEPTH, 6 * D), 0.01),
        "norm1_g": 1.0 + nrm(ks[9], (DEPTH, D), 0.02),
        "w_in": nrm(ks[10], (DEPTH, D, IN_DIM), D ** -0.5),
        "conf_dw_w": nrm(ks[11], (DEPTH, CONF_KW, CONF_CH), CONF_KW ** -0.5),
        "conf_dw_b": nrm(ks[12], (DEPTH, CONF_CH), 0.01),
        "conf_ln_g": 1.0 + nrm(ks[13], (DEPTH, CONF_CH), 0.02),
        "conf_ln_b": nrm(ks[14], (DEPTH, CONF_CH), 0.01),
        "w_conf_out": nrm(ks[15], (DEPTH, CONF_CH, D), CONF_CH ** -0.5),
        "short_conv_w": nrm(ks[16], (DEPTH, SHORT_KW, QKV_DIM), SHORT_KW ** -0.5),
        "a_log": jnp.log(jax.random.uniform(ks[18], (DEPTH, N_HEADS), jnp.float32, 1.0, 16.0)),
        "dt_bias": dt + jnp.log(-jnp.expm1(-dt)),
        "delta_norm_g": 1.0 + nrm(ks[19], (DEPTH, HEAD_V), 0.02),
        "w_delta_out": nrm(ks[20], (DEPTH, V_DIM, D), V_DIM ** -0.5),
        "w_merge_out": nrm(ks[21], (DEPTH, D, D), D ** -0.5),
        "norm2_g": 1.0 + nrm(ks[22], (DEPTH, D), 0.02),
        "w_ffn_in": nrm(ks[23], (DEPTH, D, 2 * D_FF), D ** -0.5),
        "w_ffn_out": nrm(ks[24], (DEPTH, D_FF, D), D_FF ** -0.5),
        "final_norm_g": 1.0 + nrm(ks[25], (D,), 0.02),
    }


def reference(x_prompt, x_sample, c_prompt, c_sample, state_conformer_conv, state_short_conv, state_delta,
              w_ada, b_ada, norm1_g, w_in, conf_dw_w, conf_dw_b, conf_ln_g, conf_ln_b, w_conf_out,
              short_conv_w, a_log, dt_bias, delta_norm_g, w_delta_out, w_merge_out, norm2_g,
              w_ffn_in, w_ffn_out, final_norm_g):
    bp = x_prompt.shape[0]
    xp, xs = x_prompt, x_sample
    conf_p, conf_s, short_p, short_s, delta_p, delta_s = [], [], [], [], [], []
    for l in range(DEPTH):
        weights = (w_ada[l], b_ada[l], norm1_g[l], w_in[l], conf_dw_w[l], conf_dw_b[l], conf_ln_g[l],
                   conf_ln_b[l], w_conf_out[l], short_conv_w[l], a_log[l], dt_bias[l], delta_norm_g[l],
                   w_delta_out[l], w_merge_out[l], norm2_g[l], w_ffn_in[l], w_ffn_out[l])
        xp, cb, sb, ds = hybrid_layer(
            xp, c_prompt,
            jnp.zeros((bp, CONF_KW - 1, CONF_CH), x_prompt.dtype),
            jnp.zeros((bp, SHORT_KW - 1, QKV_DIM), x_prompt.dtype),
            jnp.zeros((bp, N_HEADS, HEAD_K, HEAD_V), jnp.float32),
            *weights)
        conf_p.append(cb)
        short_p.append(sb)
        delta_p.append(ds)
        xs, cb, sb, ds = hybrid_layer(
            xs, c_sample, state_conformer_conv[l], state_short_conv[l], state_delta[l], *weights)
        conf_s.append(cb)
        short_s.append(sb)
        delta_s.append(ds)
    y_prompt = rms_norm(xp, final_norm_g)
    y_sample = rms_norm(xs, final_norm_g)
    return (y_prompt, y_sample, jnp.stack(conf_p), jnp.stack(conf_s), jnp.stack(short_p),
            jnp.stack(short_s), jnp.stack(delta_p), jnp.stack(delta_s))
```

```cpp
#include <hip/hip_runtime.h>
#include <hip/hip_cooperative_groups.h>
#include <cstdio>
#include <cstdint>
namespace cg = cooperative_groups;
__device__ __forceinline__ int pg8_ltid() { int t = threadIdx.x; asm volatile("" : "+v"(t)); return t; }
namespace pg8 {
#define PG8_LAS __attribute__((address_space(3)))
typedef unsigned short bf16_t;
typedef short bf16x8 __attribute__((ext_vector_type(8)));
typedef float f32x4 __attribute__((ext_vector_type(4)));
typedef unsigned u32x4 __attribute__((ext_vector_type(4)));
constexpr int BM = 256, BK = 64, HALF = 128, HTB = HALF * BK * 2  , STAGE_BYTES = 8 * HTB, NXCD = 8, WGM = 8;

__host__ __device__ __forceinline__ int lds_byte(int r, int c) { const int st = (r >> 4) * 2 + (c >> 5), rr = r & 15, cc = c & 31, ob = rr * 64 + cc * 2; return st * 1024 + (ob ^ (((ob >> 9) & 1) << 5)); }
__host__ __device__ __forceinline__ void stage_rc(int b, int& R, int& C) { const int st = b / 1024, sb = b % 1024, swz = sb ^ (((sb >> 9) & 1) << 5); R = (st >> 1) * 16 + swz / 64; C = (st & 1) * 32 + (swz % 64) / 2; }
__host__ __device__ __forceinline__ int perm32(int rho) { const int n = rho >> 4, i = rho & 15; return 8 * (i >> 2) + 4 * n + (i & 3); }

struct Unit { int pm, pn, seg; };
struct Gemm { const bf16_t* A; const bf16_t* Bt; int M, N, K; long dA, dB; };

struct StaticOrder {
    int nM, nN, nwg, G, c;
    __host__ __device__ void init(int M, int N, int G_, int c_) { nM = M / BM; nN = N / BM; nwg = nM * nN; G = G_; c = c_; }
    __host__ __device__ bool next(int i, Unit& u) const {
        const long L = (long)i * G + c; if (L >= nwg) return false;
        int wgid = (int)L; { const int q = nwg / NXCD, r = nwg % NXCD, xcd = wgid % NXCD, off = wgid / NXCD; wgid = (xcd < r ? xcd * (q + 1) : r * (q + 1) + (xcd - r) * q) + off; }
        const int nig = WGM * nN, gid = wgid / nig, fm = gid * WGM, gsz = (nM - fm) < WGM ? (nM - fm) : WGM;
        u.pm = fm + ((wgid % nig) % gsz); u.pn = (wgid % nig) / gsz; u.seg = 0; return true;
    }
    __device__ __forceinline__ void a_ready(const Unit&) const {}
    __device__ __forceinline__ void done(const Unit&) const {}
};
struct TwoSegOrder : StaticOrder {
    __host__ __device__ bool next(int i, Unit& u) const { if (!StaticOrder::next(i >> 1, u)) return false; u.seg = i & 1; return true; }
};


__device__ __forceinline__ unsigned cvt_pk_bf16(float lo, float hi) { unsigned r; asm volatile("v_cvt_pk_bf16_f32 %0, %1, %2" : "=v"(r) : "v"(lo), "v"(hi)); return r; }
typedef float f32x2 __attribute__((ext_vector_type(2)));
template <class Epi, class Sched, bool ALIGN_EPI = false, bool SP2 = false>
__device__ __forceinline__ void gemm_phase(PG8_LAS unsigned char* lds, const Gemm g, const Sched& S, const Epi& E) {
    const int tid = pg8_ltid(), wid = __builtin_amdgcn_readfirstlane(tid >> 6), lane = tid & 63, wr = wid >> 2, wc = wid & 3, fr = lane & 15, fq = lane >> 4;
    const int K = g.K, nt = K / BK;
    unsigned voffA[2], voffB[2];
#pragma unroll
    for (int i = 0; i < 2; ++i) { int R, C; stage_rc(tid * 16 + i * 8192, R, C); const int Rb = Epi::PERM ? ((R & ~31) + perm32(R & 31)) : R;
        voffA[i] = (unsigned)(R * K + C) * 2u; voffB[i] = (unsigned)(Rb * K + C) * 2u; }
    const size_t kstep = (size_t)(BK * 2);
    const size_t hstep = (size_t)HALF * K * 2;
    const size_t tstep = 2 * hstep;
    const unsigned ldsw = (unsigned)wid * 1024u;
    const int aoff = lds_byte(wr * 64 + fr, fq * 8), boff = lds_byte(wc * 32 + fr, fq * 8);
#define PG8_SA(b, h) (((b) * 2 + (h)) * HTB)
#define PG8_SB(b, h) ((4 + (b) * 2 + (h)) * HTB)
#define PG8_STAGE(bufoff, gbase, voff) do { _Pragma("unroll") for (int _i = 0; _i < 2; ++_i) \
        __builtin_amdgcn_global_load_lds((const unsigned*)((const char*)(gbase) + (voff)[_i]), (PG8_LAS unsigned*)(lds + (bufoff) + ldsw + _i * 8192), 16, 0, 0); } while (0)
#define PG8_LDA(dst, b, h) do { _Pragma("unroll") for (int m = 0; m < 4; ++m) _Pragma("unroll") for (int k = 0; k < 2; ++k) dst[m][k] = *(const PG8_LAS bf16x8*)(lds + PG8_SA(b, h) + aoff + m * 2048 + k * 1024); } while (0)
#define PG8_LDB(dst, b, h) do { _Pragma("unroll") for (int n = 0; n < 2; ++n) _Pragma("unroll") for (int k = 0; k < 2; ++k) dst[n][k] = *(const PG8_LAS bf16x8*)(lds + PG8_SB(b, h) + boff + n * 2048 + k * 1024); } while (0)
#define PG8_MMA(ai, bj, At, Bt) do { __builtin_amdgcn_s_setprio(1); _Pragma("unroll") for (int m = 0; m < 4; ++m) _Pragma("unroll") for (int n = 0; n < 2; ++n) _Pragma("unroll") for (int k = 0; k < 2; ++k) \
        acc[ai][bj][m][n] = __builtin_amdgcn_mfma_f32_16x16x32_bf16(Bt[n][k], At[m][k], acc[ai][bj][m][n], 0, 0, 0); __builtin_amdgcn_s_setprio(0); } while (0)
#define PG8_WAIT_V(n) asm volatile("s_waitcnt vmcnt(" #n ")" ::: "memory")
#define PG8_WAIT_L(n) asm volatile("s_waitcnt lgkmcnt(" #n ")" ::: "memory")
#define PG8_BAR __builtin_amdgcn_s_barrier()
#define PG8_SCHED __builtin_amdgcn_sched_barrier(0)
    Unit cur, nxt; int ui = 0;
    if (!S.next(0, cur)) return;
    f32x4 acc[2][2][4][2];
#pragma unroll
    for (int a = 0; a < 2; ++a)
#pragma unroll
        for (int b = 0; b < 2; ++b)
#pragma unroll
            for (int m = 0; m < 4; ++m)
#pragma unroll
                for (int n = 0; n < 2; ++n) acc[a][b][m][n] = (f32x4){0.f, 0.f, 0.f, 0.f};
    bf16x8 At[4][2], B0[2][2], B1[2][2];
    const char* cA = (const char*)g.A + (size_t)cur.pm * tstep + (cur.seg ? g.dA : 0l); const char* cB = (const char*)g.Bt + (size_t)cur.pn * tstep + (cur.seg ? g.dB : 0l);
    S.a_ready(cur);
    if constexpr (SP2) {
        PG8_STAGE(PG8_SB(0, 0), cB, voffB); PG8_STAGE(PG8_SB(0, 1), cB + hstep, voffB); PG8_STAGE(PG8_SA(0, 0), cA, voffA); PG8_STAGE(PG8_SA(0, 1), cA + hstep, voffA);
        if (wr == 1) PG8_BAR;
        PG8_WAIT_V(2); PG8_BAR;
        PG8_STAGE(PG8_SB(1, 0), cB + kstep, voffB); PG8_STAGE(PG8_SA(1, 0), cA + kstep, voffA); PG8_STAGE(PG8_SB(1, 1), cB + hstep + kstep, voffB);
        PG8_WAIT_V(6); PG8_BAR;
    } else {
        PG8_STAGE(PG8_SB(0, 0), cB, voffB); PG8_STAGE(PG8_SA(0, 0), cA, voffA); PG8_STAGE(PG8_SB(0, 1), cB + hstep, voffB); PG8_STAGE(PG8_SA(0, 1), cA + hstep, voffA);
        if (wr == 1) PG8_BAR;
        PG8_WAIT_V(4); PG8_BAR;
        PG8_STAGE(PG8_SB(1, 0), cB + kstep, voffB); PG8_STAGE(PG8_SA(1, 0), cA + kstep, voffA); PG8_STAGE(PG8_SB(1, 1), cB + hstep + kstep, voffB);
        PG8_WAIT_V(6); PG8_BAR;
    }
    for (;;) {
        const bool has_next = S.next(ui + 1, nxt);
        const char* nA = has_next ? (const char*)g.A + (size_t)nxt.pm * tstep + (nxt.seg ? g.dA : 0l) : cA; const char* nB = has_next ? (const char*)g.Bt + (size_t)nxt.pn * tstep + (nxt.seg ? g.dB : 0l) : cB;
        for (int t = 0; t < nt; t += 2) {
            const bool last = (t == nt - 2);
            const char* a1 = cA + (size_t)(t + 1) * kstep;
            const char* a2 = last ? nA : cA + (size_t)(t + 2) * kstep; const char* b2 = last ? nB : cB + (size_t)(t + 2) * kstep;
            const char* a3 = a2 + kstep; const char* b3 = b2 + kstep;
            if (last && has_next) S.a_ready(nxt);
            if constexpr (SP2) {
            PG8_LDB(B0, 0, 0); PG8_LDB(B1, 0, 1); PG8_SCHED; PG8_LDA(At, 0, 0); PG8_STAGE(PG8_SA(1, 1), a1 + hstep, voffA);
            PG8_WAIT_V(8); PG8_WAIT_L(0); PG8_BAR; PG8_MMA(0, 0, At, B0); PG8_MMA(0, 1, At, B1); PG8_BAR; PG8_SCHED;
            PG8_LDA(At, 0, 1); PG8_STAGE(PG8_SB(0, 0), b2, voffB); PG8_STAGE(PG8_SB(0, 1), b2 + hstep, voffB); PG8_STAGE(PG8_SA(0, 0), a2, voffA);
            PG8_WAIT_V(8); PG8_WAIT_L(0); PG8_BAR; PG8_MMA(1, 0, At, B0); PG8_MMA(1, 1, At, B1); PG8_BAR; PG8_SCHED;
            PG8_LDB(B0, 1, 0); PG8_LDB(B1, 1, 1); PG8_SCHED; PG8_LDA(At, 1, 0); PG8_STAGE(PG8_SA(0, 1), a2 + hstep, voffA);
            PG8_WAIT_V(8); PG8_WAIT_L(0); PG8_BAR; PG8_MMA(0, 0, At, B0); PG8_MMA(0, 1, At, B1); PG8_BAR; PG8_SCHED;
            PG8_LDA(At, 1, 1); PG8_STAGE(PG8_SB(1, 0), b3, voffB); PG8_STAGE(PG8_SB(1, 1), b3 + hstep, voffB); PG8_STAGE(PG8_SA(1, 0), a3, voffA);
            PG8_WAIT_V(8); PG8_WAIT_L(0); PG8_BAR; PG8_MMA(1, 0, At, B0); PG8_MMA(1, 1, At, B1); PG8_BAR; PG8_SCHED;
            } else {
            PG8_LDB(B0, 0, 0); PG8_SCHED; PG8_LDA(At, 0, 0); PG8_STAGE(PG8_SA(1, 1), a1 + hstep, voffA);
            PG8_WAIT_L(8); PG8_BAR; PG8_WAIT_L(0); PG8_MMA(0, 0, At, B0); PG8_BAR; PG8_SCHED;
            PG8_LDB(B1, 0, 1); PG8_STAGE(PG8_SB(0, 0), b2, voffB);
            PG8_BAR; PG8_WAIT_L(0); PG8_MMA(0, 1, At, B1); PG8_BAR;
            PG8_LDA(At, 0, 1); PG8_STAGE(PG8_SA(0, 0), a2, voffA);
            PG8_BAR; PG8_WAIT_L(0); PG8_MMA(1, 0, At, B0); PG8_BAR; PG8_SCHED;
            PG8_STAGE(PG8_SB(0, 1), b2 + hstep, voffB);
            PG8_WAIT_V(6); PG8_BAR; PG8_MMA(1, 1, At, B1); PG8_BAR;
            PG8_LDB(B0, 1, 0); PG8_SCHED; PG8_LDA(At, 1, 0); PG8_STAGE(PG8_SA(0, 1), a2 + hstep, voffA);
            PG8_WAIT_L(8); PG8_BAR; PG8_WAIT_L(0); PG8_MMA(0, 0, At, B0); PG8_BAR; PG8_SCHED;
            PG8_LDB(B1, 1, 1); PG8_STAGE(PG8_SB(1, 0), b3, voffB);
            PG8_BAR; PG8_WAIT_L(0); PG8_MMA(0, 1, At, B1); PG8_BAR;
            PG8_LDA(At, 1, 1); PG8_STAGE(PG8_SA(1, 0), a3, voffA);
            PG8_BAR; PG8_WAIT_L(0); PG8_MMA(1, 0, At, B0); PG8_BAR; PG8_SCHED;
            PG8_STAGE(PG8_SB(1, 1), b3 + hstep, voffB);
            PG8_WAIT_V(6); PG8_BAR; PG8_MMA(1, 1, At, B1); PG8_BAR;
            }
        }
        if constexpr (ALIGN_EPI) { if (wr == 0) PG8_BAR; }
        if constexpr (!Epi::AFTER_DRAIN) { E(acc, cur, wr, wc, fr, fq); S.done(cur); }
        if (!has_next) break;
        if (!(Epi::HAS_MID && cur.seg == 0)) {
#pragma unroll
        for (int a = 0; a < 2; ++a)
#pragma unroll
            for (int b = 0; b < 2; ++b)
#pragma unroll
                for (int m = 0; m < 4; ++m)
#pragma unroll
                    for (int n = 0; n < 2; ++n) acc[a][b][m][n] = (f32x4){0.f, 0.f, 0.f, 0.f};
        }
        cur = nxt; cA = nA; cB = nB; ++ui;
        if constexpr (ALIGN_EPI) { if (wr == 1) PG8_BAR; }
    }
    PG8_WAIT_V(0);
    if constexpr (!ALIGN_EPI) { if (wr == 0) PG8_BAR; }
    PG8_BAR;
    if constexpr (Epi::AFTER_DRAIN) { E.fused(acc, cur, wr, wc, fr, fq, lds, wid, lane); S.done(cur); }
#undef PG8_SA
#undef PG8_SB
#undef PG8_STAGE
#undef PG8_LDA
#undef PG8_LDB
#undef PG8_MMA
#undef PG8_WAIT_V
#undef PG8_WAIT_L
#undef PG8_BAR
#undef PG8_SCHED
}
}

#define LAS __attribute__((address_space(3)))
typedef unsigned short bf16;
typedef pg8::f32x4 f32x4; typedef pg8::bf16x8 bf16x8; typedef pg8::u32x4 u32x4;
typedef unsigned u32x2 __attribute__((ext_vector_type(2)));

#ifndef MK_ONE_LAUNCH
#define MK_ONE_LAUNCH 1
#endif

constexpr int D = 1024, MP = 16384, MS = 128, MV = MP + MS, MT = 16640, TT = 2048, NL = 4;
constexpr int CC = 512, KW = 31, HD = 128, QKVD = 1536, DFF = 2816, INDIM = 5128, NIN = 5120, NF1 = 5632, NMOD = 6144, NMODROW = 136, MODLD = 4 * NMOD;
constexpr int NPH = 43;
constexpr int LDS_BYTES = 147456;
constexpr size_t MiB = 1u << 20;
constexpr size_t WS_SC = 1 * MiB, WS_MOD = 2 * MiB, WS_BG = 15 * MiB, WS_EGL = 16 * MiB, WS_W = 18 * MiB;
constexpr size_t LW_IN = 0, LW_C = 10485760, LW_D = 11534336, LW_M = 12582912, LW_F1 = 14680064, LW_F2 = 26214400, LW_SZ = 31981568;
constexpr size_t WS_X = 140 * MiB, WS_H = 205 * MiB, WS_Y = WS_H;
constexpr size_t WS_U = 238 * MiB, WS_OB = WS_U, WS_QKV = 255 * MiB, WS_MG = WS_QKV, WS_ZS = 304 * MiB, WS_MA = 321 * MiB, WS_MB = 354 * MiB, WS_CA = 387 * MiB;
constexpr size_t WS_DW = 404 * MiB, WS_DQG = 420 * MiB, WS_DKDT = 436 * MiB, WS_DQKD = 452 * MiB, WS_DU = 460 * MiB, WS_O = 492 * MiB, WS_END = 525 * MiB;
constexpr size_t WS_HH = 238 * MiB, WS_WADA = 404 * MiB;
constexpr size_t OUT_Y = 0, OUT_CONF_P = 16908288, OUT_CONF_S = 17399808, OUT_SHORT_P = 25264128, OUT_SHORT_S = 25411584, OUT_DELTA_P = 27770880, OUT_DELTA_S = 29868032;

struct Args { const float* in[26]; float* out; unsigned char* ws; int ph_lo, ph_hi; };

__device__ __forceinline__ float bf2f(bf16 b) { return __uint_as_float(((unsigned)b) << 16); }
__device__ __forceinline__ unsigned f2bf(float f) { unsigned u = __float_as_uint(f); return (u + 0x7fffu + ((u >> 16) & 1u)) >> 16; }
typedef float f32x2_t __attribute__((ext_vector_type(2))); typedef __bf16 bf16x2_t __attribute__((ext_vector_type(2)));
__device__ __forceinline__ unsigned pk2(float lo, float hi) { f32x2_t v = {lo, hi}; bf16x2_t r = __builtin_convertvector(v, bf16x2_t); return __builtin_bit_cast(unsigned, r); }
__device__ __forceinline__ float sigm(float x) { return __builtin_amdgcn_rcpf(1.f + __expf(-x)); }
__device__ __forceinline__ float silu(float x) { return x * __builtin_amdgcn_rcpf(1.f + __expf(-x)); }
template <int CTRL, int RMASK> __device__ __forceinline__ float dpp_get(float v) { return __builtin_bit_cast(float, __builtin_amdgcn_update_dpp(0, __builtin_bit_cast(int, v), CTRL, RMASK, 0xF, false)); }
__device__ __forceinline__ float wave_sum(float v) {
    v += dpp_get<0xB1, 0xF>(v); v += dpp_get<0x4E, 0xF>(v); v += dpp_get<0x141, 0xF>(v); v += dpp_get<0x140, 0xF>(v);
    v += dpp_get<0x142, 0xA>(v); v += dpp_get<0x143, 0xC>(v);
    return __builtin_bit_cast(float, __builtin_amdgcn_readlane(__builtin_bit_cast(int, v), 63));
}
__device__ __forceinline__ float oct_sum(float v) { v += dpp_get<0xB1, 0xF>(v); v += dpp_get<0x4E, 0xF>(v); v += dpp_get<0x141, 0xF>(v); return v; }
__device__ __forceinline__ float row16_sum(float v) { v = oct_sum(v); v += dpp_get<0x140, 0xF>(v); return v; }
__device__ __forceinline__ int ltid() { int t = threadIdx.x; asm volatile("" : "+v"(t)); return t; }
__device__ __forceinline__ int lbid() { int t = blockIdx.x; asm volatile("" : "+s"(t)); return t; }
#define LDS_WAIT() asm volatile("s_waitcnt lgkmcnt(0)" ::: "memory")
#define LBAR() do { asm volatile("s_waitcnt lgkmcnt(0)" ::: "memory"); __builtin_amdgcn_s_barrier(); asm volatile("" ::: "memory"); } while (0)

#define XB_TMO      128
#define XB_XCNT(j)  (256  + 64 * (j))
#define XB_XSUB(j)  (1280 + 64 * (j))
#define XB_XGEN(j)  (2304 + 64 * (j))
#define XB_TOP      3328
#define XB_TOPGEN   3392
#define XCD_BAR_WORDS 3456
#define XB_SPIN_CAP (1u << 18)

__device__ __forceinline__ unsigned xb_ld(unsigned* p)              { return __hip_atomic_load(p, __ATOMIC_RELAXED, __HIP_MEMORY_SCOPE_AGENT); }
__device__ __forceinline__ unsigned xb_add(unsigned* p, unsigned v) { return __hip_atomic_fetch_add(p, v, __ATOMIC_RELAXED, __HIP_MEMORY_SCOPE_AGENT); }
__device__ __forceinline__ unsigned xb_xcc_id() { return (unsigned)__builtin_amdgcn_s_getreg((3 << 11) | 20) & 0xFu; }
#define XB_SPIN(cond, bar) do { unsigned _sp = 0; while (cond) { __builtin_amdgcn_s_sleep(1); \
    if ((++_sp & 255u) == 0u) { if (xb_ld(&(bar)[XB_TMO])) break; if (_sp > XB_SPIN_CAP) { atomicAdd(&(bar)[XB_TMO], 1u); break; } } } } while (0)

struct XcdBarrier {
    unsigned* bar; unsigned x;
    volatile LAS unsigned* st;
};

__device__ __forceinline__ XcdBarrier xcd_barrier_post(unsigned* bar, volatile LAS unsigned* st) {
    XcdBarrier b; b.bar = bar; b.x = xb_xcc_id(); b.st = st;
    if (threadIdx.x == 0) (void)xb_add(&bar[XB_XCNT(b.x)], 1u);
    return b;
}
__device__ __forceinline__ void xcd_barrier_complete(unsigned* bar, unsigned x, unsigned& nloc, unsigned& nx) {
    const unsigned G = gridDim.x * gridDim.y * gridDim.z;
    unsigned sum, cnt, mine, sp = 0u;
    for (;;) {
        sum = 0u; cnt = 0u; mine = 0u;
#pragma unroll
        for (unsigned j = 0; j < 16; ++j) { const unsigned c = xb_ld(&bar[XB_XCNT(j)]); sum += c; cnt += (c > 0u) ? 1u : 0u; mine = (j == x) ? c : mine; }
        if (sum == G) break;
        __builtin_amdgcn_s_sleep(1);
        if ((++sp & 255u) == 0u) { if (xb_ld(&bar[XB_TMO])) break; if (sp > XB_SPIN_CAP) { atomicAdd(&bar[XB_TMO], 1u); break; } }
    }
    nloc = mine > 0u ? mine : 1u; nx = cnt > 0u ? cnt : 1u;
}

__device__ __forceinline__ void xcd_barrier(const XcdBarrier& b) {
    asm volatile("s_waitcnt vmcnt(0)" ::: "memory");
    __syncthreads();
    if (threadIdx.x == 0) {
        unsigned* bar = b.bar;
        __builtin_amdgcn_s_waitcnt(0);
        unsigned nloc = b.st[0], nx = b.st[1];
        if (nloc == 0u) { xcd_barrier_complete(bar, b.x, nloc, nx); b.st[0] = nloc; b.st[1] = nx; }
        const unsigned old = xb_add(&bar[XB_XSUB(b.x)], 1u);
        const unsigned gen = old / nloc;
        if (old + 1u == (gen + 1u) * nloc) {
            __builtin_amdgcn_fence(__ATOMIC_RELEASE, "agent");
            asm volatile("s_waitcnt vmcnt(0)" ::: "memory");
            const unsigned og = xb_add(&bar[XB_TOP], 1u);
            const unsigned tg = og / nx;
            if (og + 1u == (tg + 1u) * nx) xb_add(&bar[XB_TOPGEN], 1u);
            else XB_SPIN(xb_ld(&bar[XB_TOPGEN]) == tg, bar);
            __builtin_amdgcn_fence(__ATOMIC_ACQUIRE, "agent");
            xb_add(&bar[XB_XGEN(b.x)], 1u);
            asm volatile("s_waitcnt vmcnt(0)" ::: "memory");
        } else {
            XB_SPIN(xb_ld(&bar[XB_XGEN(b.x)]) == gen, bar);
            __builtin_amdgcn_fence(__ATOMIC_ACQUIRE, "agent");
            asm volatile("s_waitcnt vmcnt(0)" ::: "memory");
        }
    }
    __syncthreads();
}

__device__ __forceinline__ int src_col_in(int n) { const int pn = n >> 8, r = n & 255; if (pn < 4) return ((r >> 7) ? 512 : 0) + 128 * pn + (r & 127); if (pn < 12) return n; return n + 8; }
__device__ __forceinline__ int src_col_f1(int n) { const int pn = n >> 8, r = n & 255; return ((r >> 7) ? DFF : 0) + 128 * pn + (r & 127); }

__device__ __forceinline__ void tr_item(const float* W, int Nsrc, int nsrc0, int K, bf16* WTrow0, int k0, LAS float* scr, int lane) {
    f32x4 v[8];
#pragma unroll
    for (int i = 0; i < 8; ++i) v[i] = __builtin_nontemporal_load((const f32x4*)(W + (size_t)(k0 + (lane >> 3) + 8 * i) * Nsrc + nsrc0 + 4 * (lane & 7)));
#pragma unroll
    for (int i = 0; i < 8; ++i) { LAS float* p = scr + ((lane >> 3) + 8 * i) * 33 + 4 * (lane & 7); p[0] = v[i][0]; p[1] = v[i][1]; p[2] = v[i][2]; p[3] = v[i][3]; }
    LDS_WAIT();
    const int c = lane & 7;
#pragma unroll
    for (int j = 0; j < 4; ++j) { const int n = (lane >> 3) + 8 * j; const LAS float* s = scr + (8 * c) * 33 + n;
        u32x4 o; o.x = pk2(s[0 * 33], s[1 * 33]); o.y = pk2(s[2 * 33], s[3 * 33]); o.z = pk2(s[4 * 33], s[5 * 33]); o.w = pk2(s[6 * 33], s[7 * 33]);
        *(u32x4*)(WTrow0 + (size_t)n * K + k0 + 8 * c) = o; }
    LDS_WAIT();
}
__device__ __forceinline__ void tr_mat(const float* W, int Nsrc, int K, int Ndst, int map, bf16* WT, int r, LAS float* scr, int lane) {
    const int nblk = Ndst / 32, kb = r / nblk, nb = r % nblk, n0 = 32 * nb;
    const int ns = map == 0 ? n0 : (map == 1 ? src_col_in(n0) : src_col_f1(n0));
    tr_item(W, Nsrc, ns, K, WT + (size_t)n0 * K, 64 * kb, scr, lane);
}
__device__ __forceinline__ void convert_layer(const Args& a, LAS unsigned char* lds, int l, int gw, int NGW) {
    const int tid = ltid(), lane = tid & 63, wave = tid >> 6;
    LAS float* scr = (LAS float*)(lds + wave * 16384);
    constexpr int I_IN = 16 * 160, I_C = 8 * 32, I_M = 16 * 32, I_F1 = 16 * 176, I_F2 = 44 * 32, I_LAYER = I_IN + 2 * I_C + I_M + I_F1 + I_F2;
    unsigned char* lw = a.ws + WS_W + (size_t)l * LW_SZ;
    for (int it = gw; it < I_LAYER; it += NGW) {
        int r = it;
        if (r < I_IN) { tr_mat(a.in[10] + (size_t)l * 1024 * INDIM, INDIM, 1024, NIN, 1, (bf16*)(lw + LW_IN), r, scr, lane); continue; } r -= I_IN;
        if (r < I_C) { tr_mat(a.in[15] + (size_t)l * 512 * 1024, 1024, 512, 1024, 0, (bf16*)(lw + LW_C), r, scr, lane); continue; } r -= I_C;
        if (r < I_C) { tr_mat(a.in[20] + (size_t)l * 512 * 1024, 1024, 512, 1024, 0, (bf16*)(lw + LW_D), r, scr, lane); continue; } r -= I_C;
        if (r < I_M) { tr_mat(a.in[21] + (size_t)l * 1024 * 1024, 1024, 1024, 1024, 0, (bf16*)(lw + LW_M), r, scr, lane); continue; } r -= I_M;
        if (r < I_F1) { tr_mat(a.in[23] + (size_t)l * 1024 * NF1, NF1, 1024, NF1, 2, (bf16*)(lw + LW_F1), r, scr, lane); continue; } r -= I_F1;
        tr_mat(a.in[24] + (size_t)l * DFF * 1024, 1024, DFF, 1024, 0, (bf16*)(lw + LW_F2), r, scr, lane);
    }
}
__device__ __forceinline__ void phase_p0a(const Args& a, LAS unsigned char* lds) {
    const int tid = ltid(), lane = tid & 63, wave = tid >> 6, bid = lbid();
    LAS float* scr = (LAS float*)(lds + wave * 16384);
    const int gw = bid * 8 + wave, NGW = gridDim.x * 8;
    constexpr int I_ADA = 16 * 192;
    for (int it = gw; it < 4 * I_ADA; it += NGW) { const int l = it / I_ADA, r = it - l * I_ADA;
        tr_mat(a.in[7] + (size_t)l * 1024 * NMOD, NMOD, 1024, NMOD, 0, (bf16*)(a.ws + WS_WADA) + (size_t)l * NMOD * 1024, r, scr, lane); }
    bf16* SC = (bf16*)(a.ws + WS_SC);
    for (int i = bid * 512 + tid; i < 256 * 1024 / 2; i += gridDim.x * 512) {
        const int row = (2 * i) >> 10, k = (2 * i) & 1023;
        float v0 = 0.f, v1 = 0.f;
        if (row < 8) { v0 = a.in[2][row * 1024 + k]; v1 = a.in[2][row * 1024 + k + 1]; }
        else if (row < NMODROW) { v0 = a.in[3][(row - 8) * 1024 + k]; v1 = a.in[3][(row - 8) * 1024 + k + 1]; }
        ((unsigned*)SC)[i] = pk2(silu(v0), silu(v1));
    }
}

template <int ACT>
__device__ __forceinline__ void epi_store_bf16(const f32x4 (&acc)[2][2][4][2], bf16* base, int ldc, int row0, int col0) {
#pragma unroll
    for (int ai = 0; ai < 2; ++ai)
#pragma unroll
        for (int m = 0; m < 4; ++m) { bf16* rowp = base + (size_t)(row0 + ai * 128 + m * 16) * ldc + col0;
#pragma unroll
            for (int bj = 0; bj < 2; ++bj) { f32x4 v0 = acc[ai][bj][m][0], v1 = acc[ai][bj][m][1];
                if (ACT == 1) {
#pragma unroll
                    for (int j = 0; j < 4; ++j) { v0[j] = silu(v0[j]); v1[j] = silu(v1[j]); } }
                if (ACT == 2) {
#pragma unroll
                    for (int j = 0; j < 4; ++j) { v0[j] = sigm(v0[j]); v1[j] = sigm(v1[j]); } }
                u32x4 w; w.x = pk2(v0[0], v0[1]); w.y = pk2(v0[2], v0[3]); w.z = pk2(v1[0], v1[1]); w.w = pk2(v1[2], v1[3]);
                *(u32x4*)(rowp + bj * 128) = w; __builtin_amdgcn_sched_barrier(0); } }
}
template <int MODE>
__device__ __forceinline__ void epi_store_glu(const f32x4 (&acc)[2][2][4][2], bf16* base, int ldc, int row0, int col0) {
#pragma unroll
    for (int ai = 0; ai < 2; ++ai)
#pragma unroll
        for (int m = 0; m < 4; ++m) { bf16* rowp = base + (size_t)(row0 + ai * 128 + m * 16) * ldc + col0;
            f32x4 v[2];
#pragma unroll
            for (int n = 0; n < 2; ++n)
#pragma unroll
                for (int j = 0; j < 4; ++j) { const float x = acc[ai][0][m][n][j], y = acc[ai][1][m][n][j]; v[n][j] = MODE == 0 ? x * sigm(y) : silu(x) * y; }
            u32x4 w; w.x = pk2(v[0][0], v[0][1]); w.y = pk2(v[0][2], v[0][3]); w.z = pk2(v[1][0], v[1][1]); w.w = pk2(v[1][2], v[1][3]);
            *(u32x4*)rowp = w; __builtin_amdgcn_sched_barrier(0); }
}
struct EpiIn { static constexpr bool PERM = true, AFTER_DRAIN = false, HAS_MID = false; bf16 *U, *QKV, *ZS, *MA, *MB;
    __device__ __forceinline__ void operator()(const f32x4 (&acc)[2][2][4][2], const pg8::Unit& u, int wr, int wc, int fr, int fq) const {
        const int row0 = u.pm * 256 + wr * 64 + fr, cw = wc * 32 + 8 * fq, pn = u.pn;
        if (pn < 4) epi_store_glu<0>(acc, U, CC, row0, 128 * pn + cw);
        else if (pn < 10) epi_store_bf16<0>(acc, QKV, QKVD, row0, 256 * (pn - 4) + cw);
        else if (pn < 12) epi_store_bf16<1>(acc, ZS, CC, row0, 256 * (pn - 10) + cw);
        else if (pn < 16) epi_store_bf16<2>(acc, MA, D, row0, 256 * (pn - 12) + cw);
        else epi_store_bf16<2>(acc, MB, D, row0, 256 * (pn - 16) + cw);
    }
};
struct EpiSwi { static constexpr bool PERM = true, AFTER_DRAIN = false, HAS_MID = false; bf16* HH;
    __device__ __forceinline__ void operator()(const f32x4 (&acc)[2][2][4][2], const pg8::Unit& u, int wr, int wc, int fr, int fq) const {
        epi_store_glu<1>(acc, HH, DFF, u.pm * 256 + wr * 64 + fr, 128 * u.pn + wc * 32 + 8 * fq);
    }
};
template <bool ADD> struct EpiGate { static constexpr bool PERM = true, AFTER_DRAIN = false, HAS_MID = false; const bf16* G; const bf16* Yin; bf16* Out;
    __device__ __forceinline__ void operator()(const f32x4 (&acc)[2][2][4][2], const pg8::Unit& u, int wr, int wc, int fr, int fq) const {
        const int row0 = u.pm * 256 + wr * 64 + fr, col0 = u.pn * 256 + wc * 32 + 8 * fq;
#pragma unroll
        for (int ai = 0; ai < 2; ++ai)
#pragma unroll
            for (int m = 0; m < 4; ++m) { const size_t off = (size_t)(row0 + ai * 128 + m * 16) * D + col0;
#pragma unroll
                for (int bj = 0; bj < 2; ++bj) {
                    const u32x4 g = *(const u32x4*)(G + off + bj * 128); u32x4 y = (u32x4){0u, 0u, 0u, 0u}; if (ADD) y = *(const u32x4*)(Yin + off + bj * 128);
                    float o[8];
#pragma unroll
                    for (int j = 0; j < 8; ++j) { const unsigned gw = g[j >> 1], yw = y[j >> 1];
                        const float gf = (j & 1) ? __uint_as_float(gw & 0xffff0000u) : __uint_as_float(gw << 16);
                        const float yf = (j & 1) ? __uint_as_float(yw & 0xffff0000u) : __uint_as_float(yw << 16);
                        o[j] = (ADD ? yf : 0.f) + gf * acc[ai][bj][m][j >> 2][j & 3]; }
                    u32x4 w; w.x = pk2(o[0], o[1]); w.y = pk2(o[2], o[3]); w.z = pk2(o[4], o[5]); w.w = pk2(o[6], o[7]);
                    *(u32x4*)(Out + off + bj * 128) = w; } }
    }
};
struct EpiMerge { static constexpr bool PERM = true, AFTER_DRAIN = false, HAS_MID = true; const bf16* SA; const bf16* SB; bf16* Out;
    __device__ __forceinline__ void operator()(f32x4 (&acc)[2][2][4][2], const pg8::Unit& u, int wr, int wc, int fr, int fq) const {
        const int row0 = u.pm * 256 + wr * 64 + fr, col0 = u.pn * 256 + wc * 32 + 8 * fq;
#pragma unroll
        for (int ai = 0; ai < 2; ++ai)
#pragma unroll
            for (int m = 0; m < 4; ++m) { const size_t off = (size_t)(row0 + ai * 128 + m * 16) * D + col0;
#pragma unroll
                for (int bj = 0; bj < 2; ++bj) {
                    if (u.seg == 0) { const u32x4 sa = *(const u32x4*)(SA + off + bj * 128), sb = *(const u32x4*)(SB + off + bj * 128);
#pragma unroll
                        for (int j = 0; j < 8; ++j) { const unsigned aw = sa[j >> 1], bw = sb[j >> 1];
                            const float af = (j & 1) ? __uint_as_float(aw & 0xffff0000u) : __uint_as_float(aw << 16);
                            const float bf = (j & 1) ? __uint_as_float(bw & 0xffff0000u) : __uint_as_float(bw << 16);
                            acc[ai][bj][m][j >> 2][j & 3] *= bf * __builtin_amdgcn_rcpf(fmaxf(af, 1e-30f)); } }
                    else { const u32x4 sa = *(const u32x4*)(SA + off + bj * 128);
                        float o[8];
#pragma unroll
                        for (int j = 0; j < 8; ++j) { const unsigned aw = sa[j >> 1]; const float af = (j & 1) ? __uint_as_float(aw & 0xffff0000u) : __uint_as_float(aw << 16);
                            o[j] = af * acc[ai][bj][m][j >> 2][j & 3]; }
                        u32x4 w; w.x = pk2(o[0], o[1]); w.y = pk2(o[2], o[3]); w.z = pk2(o[4], o[5]); w.w = pk2(o[6], o[7]);
                        *(u32x4*)(Out + off + bj * 128) = w; } } }
    }
};
struct EpiRes { static constexpr bool PERM = false, AFTER_DRAIN = false, HAS_MID = false; const float* xp; const float* xs; const float* Xin; float* Xout; const float* gt; int use_in;
    __device__ __forceinline__ void operator()(const f32x4 (&acc)[2][2][4][2], const pg8::Unit& u, int wr, int wc, int fr, int fq) const {
        const int row0 = u.pm * 256 + wr * 64 + fr, col0 = u.pn * 256 + wc * 32 + 4 * fq;
#pragma unroll
        for (int ai = 0; ai < 2; ++ai)
#pragma unroll
            for (int m = 0; m < 4; ++m) { const int row = row0 + ai * 128 + m * 16;
                if (row < MV) {
                    const float* xi = use_in ? (row < MP ? xp + (size_t)row * D : xs + (size_t)(row - MP) * D) : Xin + (size_t)row * D;
                    const int mr = row < MP ? (row >> 11) : 8 + (row - MP);
                    const float* g = gt + (size_t)mr * MODLD; float* xo = Xout + (size_t)row * D;
#pragma unroll
                    for (int bj = 0; bj < 2; ++bj)
#pragma unroll
                        for (int n = 0; n < 2; ++n) { const int c = col0 + bj * 128 + n * 16;
                            *(f32x4*)(xo + c) = *(const f32x4*)(xi + c) + *(const f32x4*)(g + c) * acc[ai][bj][m][n]; } } }
    }
};
struct EpiMod { static constexpr bool PERM = false, AFTER_DRAIN = false, HAS_MID = false; float* MOD; const float* bias;
    __device__ __forceinline__ void operator()(const f32x4 (&acc)[2][2][4][2], const pg8::Unit& u, int wr, int wc, int fr, int fq) const {
        const int row0 = u.pm * 256 + wr * 64 + fr, col0 = u.pn * 256 + wc * 32 + 4 * fq;
#pragma unroll
        for (int ai = 0; ai < 2; ++ai)
#pragma unroll
            for (int m = 0; m < 4; ++m) { const int row = row0 + ai * 128 + m * 16;
                if (row < NMODROW) {
#pragma unroll
                    for (int bj = 0; bj < 2; ++bj)
#pragma unroll
                        for (int n = 0; n < 2; ++n) { const int c = col0 + bj * 128 + n * 16;
                            *(f32x4*)(MOD + (size_t)row * MODLD + c) = *(const f32x4*)(bias + c) + acc[ai][bj][m][n]; } } }
    }
};

template <int RT, int CT, int BS = 4, class EpiS>
__device__ __forceinline__ void splitk_units(LAS unsigned char* lds, const bf16* As, const bf16* Bt, int K, int NCG, const EpiS& E, int bid = -1, int G = 0) {
    const int tid = ltid(), lane = tid & 63, w = tid >> 6, fr = lane & 15, fq = lane >> 4;
    if (bid < 0) { bid = lbid(); G = (int)gridDim.x; }
    const int n_units = (8 / RT) * NCG, kw = K >> 3, nks = kw >> 5;
    LAS f32x4* part = (LAS f32x4*)lds;
    for (int u = bid; u < n_units; u += G) {
        const int rg = u / NCG, cg = u % NCG;
        const bf16* ap[RT]; const bf16* bp[CT];
#pragma unroll
        for (int r = 0; r < RT; ++r) ap[r] = As + (size_t)(16 * (rg * RT + r) + fr) * K + w * kw + 8 * fq;
#pragma unroll
        for (int c = 0; c < CT; ++c) bp[c] = Bt + (size_t)(E.brow(cg, c) + fr) * K + w * kw + 8 * fq;
        f32x4 acc[RT][CT];
#pragma unroll
        for (int r = 0; r < RT; ++r)
#pragma unroll
            for (int c = 0; c < CT; ++c) acc[r][c] = (f32x4){0.f, 0.f, 0.f, 0.f};
#pragma unroll 1
        for (int s0 = 0; s0 < nks; s0 += BS) {
            bf16x8 av[BS][RT], bv[BS][CT];
#pragma unroll
            for (int s = 0; s < BS; ++s) { const int so = (s0 + s < nks) ? 32 * (s0 + s) : 32 * s0;
#pragma unroll
                for (int r = 0; r < RT; ++r) av[s][r] = *(const bf16x8*)(ap[r] + so);
#pragma unroll
                for (int c = 0; c < CT; ++c) bv[s][c] = *(const bf16x8*)(bp[c] + so); }
#pragma unroll
            for (int s = 0; s < BS; ++s) if (s0 + s < nks) {
#pragma unroll
                for (int r = 0; r < RT; ++r)
#pragma unroll
                    for (int c = 0; c < CT; ++c) acc[r][c] = __builtin_amdgcn_mfma_f32_16x16x32_bf16(av[s][r], bv[s][c], acc[r][c], 0, 0, 0); }
        }
#pragma unroll
        for (int r = 0; r < RT; ++r)
#pragma unroll
            for (int c = 0; c < CT; ++c) part[((w * RT + r) * CT + c) * 64 + lane] = acc[r][c];
        LBAR();
        if (w < RT) { f32x4 sum[CT];
#pragma unroll
            for (int c = 0; c < CT; ++c) { f32x4 s = part[((0 * RT + w) * CT + c) * 64 + lane];
#pragma unroll
                for (int ww = 1; ww < 8; ++ww) s += part[((ww * RT + w) * CT + c) * 64 + lane];
                sum[c] = s; }
            E(cg, 16 * (rg * RT + w) + 4 * fq, fr, sum); }
        LBAR();
    }
}
struct SkGlu { static constexpr int CT = 2; bf16* U;
    __device__ __forceinline__ int brow(int cg, int c) const { const int oc = 16 * cg; return 256 * (oc >> 7) + (oc & 127) + 128 * c; }
    __device__ __forceinline__ void operator()(int cg, int s0, int fr, const f32x4 (&a)[2]) const {
#pragma unroll
        for (int e = 0; e < 4; ++e) U[(size_t)(MP + s0 + e) * CC + 16 * cg + fr] = (bf16)f2bf(a[0][e] * sigm(a[1][e])); }
};
struct SkIn { static constexpr int CT = 4; bf16 *QKV, *ZS, *MA, *MB;
    __device__ __forceinline__ int brow(int cg, int c) const { return 1024 + 64 * cg + 16 * c; }
    __device__ __forceinline__ void operator()(int cg, int s0, int fr, const f32x4 (&a)[4]) const {
#pragma unroll
        for (int c = 0; c < 4; ++c) { const int n = 1024 + 64 * cg + 16 * c + fr;
#pragma unroll
            for (int e = 0; e < 4; ++e) { const size_t r = (size_t)(MP + s0 + e); const float v = a[c][e];
                if (n < 2560) QKV[r * QKVD + n - 1024] = (bf16)f2bf(v);
                else if (n < 3072) ZS[r * CC + n - 2560] = (bf16)f2bf(silu(v));
                else if (n < 4096) MA[r * D + n - 3072] = (bf16)f2bf(sigm(v));
                else MB[r * D + n - 4096] = (bf16)f2bf(sigm(v)); } } }
};
struct SkInAll { static constexpr int CT = 5; bf16 *U, *QKV, *ZS, *MA, *MB;
    __device__ __forceinline__ int plain_tile(int cg, int c) const { return cg < 32 ? 3 * cg + (c - 2) : 96 + 5 * (cg - 32) + c; }
    __device__ __forceinline__ int brow(int cg, int c) const { if (cg < 32 && c < 2) { const int oc = 16 * cg; return 256 * (oc >> 7) + (oc & 127) + 128 * c; } return 1024 + 16 * plain_tile(cg, c); }
    __device__ __forceinline__ void operator()(int cg, int s0, int fr, const f32x4 (&a)[5]) const {
        if (cg < 32) {
#pragma unroll
            for (int e = 0; e < 4; ++e) U[(size_t)(MP + s0 + e) * CC + 16 * cg + fr] = (bf16)f2bf(a[0][e] * sigm(a[1][e])); }
#pragma unroll
        for (int c = 0; c < 5; ++c) { if (cg < 32 && c < 2) continue;
            const int n = 1024 + 16 * plain_tile(cg, c) + fr;
#pragma unroll
            for (int e = 0; e < 4; ++e) { const size_t r = (size_t)(MP + s0 + e); const float v = a[c][e];
                if (n < 2560) QKV[r * QKVD + n - 1024] = (bf16)f2bf(v);
                else if (n < 3072) ZS[r * CC + n - 2560] = (bf16)f2bf(silu(v));
                else if (n < 4096) MA[r * D + n - 3072] = (bf16)f2bf(sigm(v));
                else MB[r * D + n - 4096] = (bf16)f2bf(sigm(v)); } }
    }
};
template <bool ADD> struct SkGate { static constexpr int CT = 2; const bf16* G; const bf16* Yin; bf16* Out;
    __device__ __forceinline__ int brow(int cg, int c) const { return 32 * cg + 16 * c; }
    __device__ __forceinline__ void operator()(int cg, int s0, int fr, const f32x4 (&a)[2]) const {
#pragma unroll
        for (int c = 0; c < 2; ++c)
#pragma unroll
            for (int e = 0; e < 4; ++e) { const size_t o = (size_t)(MP + s0 + e) * D + 32 * cg + 16 * c + fr;
                Out[o] = (bf16)f2bf((ADD ? bf2f(Yin[o]) : 0.f) + bf2f(G[o]) * a[c][e]); } }
};
struct SkRes { static constexpr int CT = 2; const float* xs; const float* Xin; float* Xout; const float* gt; int use_in;
    __device__ __forceinline__ int brow(int cg, int c) const { return 32 * cg + 16 * c; }
    __device__ __forceinline__ void operator()(int cg, int s0, int fr, const f32x4 (&a)[2]) const {
#pragma unroll
        for (int e = 0; e < 4; ++e) { const int s = s0 + e; const float* xi = use_in ? xs + (size_t)s * D : Xin + (size_t)(MP + s) * D;
#pragma unroll
            for (int c = 0; c < 2; ++c) { const int col = 32 * cg + 16 * c + fr;
                Xout[(size_t)(MP + s) * D + col] = xi[col] + gt[(size_t)(8 + s) * MODLD + col] * a[c][e]; } } }
};
template <class Epi> __device__ __forceinline__ void run_gemm_sub(LAS unsigned char* lds, const bf16* A, const bf16* Bt, int M, int N, int K, const Epi& E, int c, int G) {
    pg8::Gemm g{A, Bt, M, N, K}; pg8::StaticOrder S; S.init(M, N, G, c);
    pg8::gemm_phase<Epi, pg8::StaticOrder, true, true>(lds, g, S, E);
}
template <class Epi> __device__ __forceinline__ void run_gemm(LAS unsigned char* lds, const bf16* A, const bf16* Bt, int M, int N, int K, const Epi& E) {
    pg8::Gemm g{A, Bt, M, N, K}; pg8::StaticOrder S; S.init(M, N, (int)gridDim.x, lbid());
    pg8::gemm_phase<Epi, pg8::StaticOrder, true, true>(lds, g, S, E);
}

__device__ __forceinline__ const float* xrow_ptr(const Args& a, int use_in, int m) {
    return use_in ? (m < MP ? a.in[0] + (size_t)m * D : a.in[1] + (size_t)(m - MP) * D) : (const float*)(a.ws + WS_X) + (size_t)m * D;
}
template <int WHICH>
__device__ __forceinline__ void norm_row(const Args& a, int l, int m, f32x4 (&v)[4], const f32x4 (&gs)[4], const f32x4 (&shv)[4], LAS float* wba, int lane) {
    float ss = 0.f;
#pragma unroll
    for (int j = 0; j < 4; ++j) ss += (v[j][0] * v[j][0] + v[j][1] * v[j][1]) + (v[j][2] * v[j][2] + v[j][3] * v[j][3]);
    const float rstd = rsqrtf(wave_sum(ss) * (1.f / D) + 1e-6f);
    u32x2* hp = (u32x2*)((bf16*)(a.ws + WS_H) + (size_t)m * D) + lane;
#pragma unroll
    for (int j = 0; j < 4; ++j) { v[j] = v[j] * rstd * gs[j] + shv[j];
        u32x2 o; o.x = pk2(v[j][0], v[j][1]); o.y = pk2(v[j][2], v[j][3]); hp[64 * j] = o; }
    if (WHICH == 0) {
        float p[8];
#pragma unroll
        for (int c = 0; c < 8; ++c) { float s = 0.f;
#pragma unroll
            for (int j = 0; j < 4; ++j) { const f32x4 w = *(const LAS f32x4*)(wba + c * 1024 + 4 * (lane + 64 * j)); s += (v[j][0] * w[0] + v[j][1] * w[1]) + (v[j][2] * w[2] + v[j][3] * w[3]); }
            p[c] = wave_sum(s); if (c & 1) __builtin_amdgcn_sched_barrier(0); }
        float val = p[0];
#pragma unroll
        for (int c = 1; c < 8; ++c) val = (lane == c) ? p[c] : val;
        if (lane < 8) { const int hh = lane & 3; float o;
            if (lane < 4) o = sigm(val);
            else { const float x = val + a.in[18][l * 4 + hh]; const float sp = x > 20.f ? x : log1pf(__expf(x)); o = -__expf(a.in[17][l * 4 + hh]) * sp; }
            ((float*)(a.ws + WS_BG))[(size_t)m * 8 + lane] = o; }
    }
}
template <int WHICH>
__device__ __forceinline__ void load_mod(const Args& a, int l, int mr, int lane, f32x4 (&gs)[4], f32x4 (&shv)[4]) {
    const float* mrow = (const float*)(a.ws + WS_MOD) + (size_t)l * NMOD + (size_t)mr * MODLD;
    const f32x4* scp = (const f32x4*)(mrow + (WHICH == 0 ? 1 : 4) * D) + lane; const f32x4* shp = (const f32x4*)(mrow + (WHICH == 0 ? 0 : 3) * D) + lane;
    const f32x4* gp = (const f32x4*)((WHICH == 0 ? a.in[9] : a.in[22]) + (size_t)l * D) + lane;
#pragma unroll
    for (int j = 0; j < 4; ++j) { gs[j] = gp[64 * j] * (scp[64 * j] + 1.f); shv[j] = shp[64 * j]; }
}
template <int WHICH>
__device__ __forceinline__ void phase_norm(const Args& a, LAS unsigned char* lds, int l) {
    const int tid = ltid(), lane = tid & 63, wave = tid >> 6;
    LAS float* wba = (LAS float*)lds;
    if (WHICH == 0) {
        const float* win = a.in[10] + (size_t)l * 1024 * INDIM;
        for (int idx = tid; idx < 8192; idx += 512) { const int k = idx >> 3, c = idx & 7; wba[c * 1024 + k] = win[(size_t)k * INDIM + 3072 + c]; }
        LBAR();
    }
    const int use_in = (WHICH == 0 && l == 0);
    const int gw = lbid() * 8 + wave, NGW = gridDim.x * 8;
    for (int g = gw; g < MP / 8; g += NGW) { const int m0 = 8 * g;
        f32x4 vn[4], vn2[4], gs[4], shv[4];
        { const f32x4* xr = (const f32x4*)xrow_ptr(a, use_in, m0) + lane; const f32x4* xr2 = (const f32x4*)xrow_ptr(a, use_in, m0 + 1) + lane;
#pragma unroll
            for (int j = 0; j < 4; ++j) { vn[j] = xr[64 * j]; vn2[j] = xr2[64 * j]; } }
        load_mod<WHICH>(a, l, m0 >> 11, lane, gs, shv);
#pragma unroll 1
        for (int i = 0; i < 8; ++i) { f32x4 v[4];
#pragma unroll
            for (int j = 0; j < 4; ++j) { v[j] = vn[j]; vn[j] = vn2[j]; }
            if (i + 2 < 8) { const f32x4* xr = (const f32x4*)xrow_ptr(a, use_in, m0 + i + 2) + lane;
#pragma unroll
                for (int j = 0; j < 4; ++j) vn2[j] = xr[64 * j]; }
            norm_row<WHICH>(a, l, m0 + i, v, gs, shv, wba, lane); }
    }
    for (int s = gw; s < MS; s += NGW) { f32x4 v[4], gs[4], shv[4];
        const f32x4* xr = (const f32x4*)xrow_ptr(a, use_in, MP + s) + lane;
#pragma unroll
        for (int j = 0; j < 4; ++j) v[j] = xr[64 * j];
        load_mod<WHICH>(a, l, 8 + s, lane, gs, shv);
        norm_row<WHICH>(a, l, MP + s, v, gs, shv, wba, lane); }
    if (WHICH == 0) LBAR();
}
__device__ __forceinline__ void phase_final(const Args& a) {
    const int tid = ltid(), lane = tid & 63, wave = tid >> 6;
    const int gw = lbid() * 8 + wave, NGW = gridDim.x * 8;
    const f32x4* gp = (const f32x4*)a.in[25] + lane;
    f32x4 vn[4], vn2[4];
    if (gw < MV) { const f32x4* xr = (const f32x4*)((const float*)(a.ws + WS_X) + (size_t)gw * D) + lane;
#pragma unroll
        for (int j = 0; j < 4; ++j) vn[j] = xr[64 * j]; }
    if (gw + NGW < MV) { const f32x4* xr = (const f32x4*)((const float*)(a.ws + WS_X) + (size_t)(gw + NGW) * D) + lane;
#pragma unroll
        for (int j = 0; j < 4; ++j) vn2[j] = xr[64 * j]; }
    for (int m = gw; m < MV; m += NGW) {
        f32x4 v[4]; float ss = 0.f;
#pragma unroll
        for (int j = 0; j < 4; ++j) { v[j] = vn[j]; vn[j] = vn2[j]; ss += (v[j][0] * v[j][0] + v[j][1] * v[j][1]) + (v[j][2] * v[j][2] + v[j][3] * v[j][3]); }
        if (m + 2 * NGW < MV) { const f32x4* xr = (const f32x4*)((const float*)(a.ws + WS_X) + (size_t)(m + 2 * NGW) * D) + lane;
#pragma unroll
            for (int j = 0; j < 4; ++j) vn2[j] = xr[64 * j]; }
        const float rstd = rsqrtf(wave_sum(ss) * (1.f / D) + 1e-6f);
        f32x4* op = (f32x4*)(a.out + OUT_Y + (size_t)m * D) + lane;
#pragma unroll
        for (int j = 0; j < 4; ++j) __builtin_nontemporal_store(v[j] * rstd * gp[64 * j], op + 64 * j);
    }
}

__device__ __forceinline__ void conv_prompt_item(const Args& a, LAS unsigned char* lds, int l, int b, int tb) {
    const int tid = ltid(), lane = tid & 63, wave = tid >> 6;
    LAS bf16* UT = (LAS bf16*)lds;
    LAS float* YT = (LAS float*)(lds + 98304);
    const bf16* U = (const bf16*)(a.ws + WS_U); bf16* CA = (bf16*)(a.ws + WS_CA);
    const int m0 = b * TT + 64 * tb;
    for (int idx = tid; idx < 94 * 64; idx += 512) { const int r = idx >> 6, c16 = idx & 63, t = 64 * tb - 30 + r;
        u32x4 v = (u32x4){0u, 0u, 0u, 0u}; if (t >= 0) v = *(const u32x4*)(U + (size_t)(b * TT + t) * CC + c16 * 8);
        *(LAS u32x4*)(UT + r * CC + c16 * 8) = v; }
    const int c = tid;
    float w[KW];
#pragma unroll
    for (int j = 0; j < KW; ++j) w[j] = a.in[11][(size_t)(l * KW + j) * CC + c];
    const float bias = a.in[12][l * CC + c];
    f32x4 lg[2], lb[2];
#pragma unroll
    for (int q = 0; q < 2; ++q) { lg[q] = *(const f32x4*)(a.in[13] + l * CC + 8 * lane + 4 * q); lb[q] = *(const f32x4*)(a.in[14] + l * CC + 8 * lane + 4 * q); }
    LBAR();
#pragma unroll 1
    for (int qt = 0; qt < 4; ++qt) {
#pragma unroll 1
        for (int g2 = 0; g2 < 2; ++g2) { const int g = 2 * qt + g2;
            float y[8];
#pragma unroll
            for (int t = 0; t < 8; ++t) y[t] = bias;
            const LAS bf16* up = UT + (8 * g) * CC + c;
#pragma unroll
            for (int ib = 0; ib < 38; ib += 8) {
                float xv[8];
#pragma unroll
                for (int i2 = 0; i2 < 8; ++i2) xv[i2] = (ib + i2 < 38) ? bf2f(up[(ib + i2) * CC]) : 0.f;
#pragma unroll
                for (int i2 = 0; i2 < 8; ++i2) { const int i = ib + i2;
#pragma unroll
                    for (int t = 0; t < 8; ++t) { const int j = i - t; if (i < 38 && j >= 0 && j < KW) y[t] += w[j] * xv[i2]; } }
            }
#pragma unroll
            for (int t = 0; t < 8; ++t) YT[(8 * g2 + t) * CC + c] = y[t];
        }
        LBAR();
#pragma unroll
        for (int tt = 0; tt < 2; ++tt) { const int tl = 2 * wave + tt;
            const f32x4 v0 = *(const LAS f32x4*)(YT + tl * CC + 8 * lane), v1 = *(const LAS f32x4*)(YT + tl * CC + 8 * lane + 4);
            const float s = wave_sum((v0[0] + v0[1]) + (v0[2] + v0[3]) + (v1[0] + v1[1]) + (v1[2] + v1[3]));
            const float mu = s * (1.f / CC);
            const f32x4 d0 = v0 - mu, d1 = v1 - mu;
            const float q = wave_sum((d0[0] * d0[0] + d0[1] * d0[1]) + (d0[2] * d0[2] + d0[3] * d0[3]) + (d1[0] * d1[0] + d1[1] * d1[1]) + (d1[2] * d1[2] + d1[3] * d1[3]));
            const float rstd = rsqrtf(q * (1.f / CC) + 1e-5f);
            float o[8];
#pragma unroll
            for (int e = 0; e < 4; ++e) { o[e] = silu(d0[e] * rstd * lg[0][e] + lb[0][e]); o[4 + e] = silu(d1[e] * rstd * lg[1][e] + lb[1][e]); }
            u32x4 pw; pw.x = pk2(o[0], o[1]); pw.y = pk2(o[2], o[3]); pw.z = pk2(o[4], o[5]); pw.w = pk2(o[6], o[7]);
            *(u32x4*)(CA + (size_t)(m0 + 16 * qt + tl) * CC + 8 * lane) = pw; }
        LBAR();
    }
    if (tb == 31) { float* o = a.out + OUT_CONF_P + (size_t)((l * 8 + b) * 30) * CC + c;
#pragma unroll 6
        for (int i = 0; i < 30; ++i) o[(size_t)i * CC] = bf2f(UT[(64 + i) * CC + c]); }
    LBAR();
}
__device__ __forceinline__ void conv_sample_item(const Args& a, LAS unsigned char* lds, int l, int s) {
    const int tid = ltid(), lane = tid & 63, wave = tid >> 6, c = tid;
    LAS float* red = (LAS float*)lds;
    const float* st = a.in[4] + (size_t)((l * MS + s) * 30) * CC + c; float* so = a.out + OUT_CONF_S + (size_t)((l * MS + s) * 30) * CC + c;
    float y = a.in[12][l * CC + c];
    float xs[30];
#pragma unroll
    for (int j = 0; j < 30; ++j) xs[j] = st[(size_t)j * CC];
#pragma unroll
    for (int j = 0; j < 30; ++j) { y += a.in[11][(size_t)(l * KW + j) * CC + c] * xs[j]; if (j >= 1) so[(size_t)(j - 1) * CC] = xs[j]; }
    const float un = bf2f(((const bf16*)(a.ws + WS_U))[(size_t)(MP + s) * CC + c]);
    y += a.in[11][(size_t)(l * KW + 30) * CC + c] * un; so[(size_t)29 * CC] = un;
    const float sv = wave_sum(y), qv = wave_sum(y * y);
    if (lane == 0) { red[wave * 2] = sv; red[wave * 2 + 1] = qv; }
    LBAR();
    float S = 0.f, Q = 0.f;
#pragma unroll
    for (int ww = 0; ww < 8; ++ww) { S += red[ww * 2]; Q += red[ww * 2 + 1]; }
    const float mu = S * (1.f / CC), var = fmaxf(Q * (1.f / CC) - mu * mu, 0.f), rstd = rsqrtf(var + 1e-5f);
    const float o = silu((y - mu) * rstd * a.in[13][l * CC + c] + a.in[14][l * CC + c]);
    ((bf16*)(a.ws + WS_CA))[(size_t)(MP + s) * CC + c] = (bf16)f2bf(o);
    LBAR();
}
__device__ __forceinline__ void delta_local_load(const Args& a, int it, u32x4 (&xr)[11]) {
    const int tid = ltid(); if (tid >= 384) return;
    const int b = it >> 7, h = (it >> 5) & 3, n = it & 31, m0 = b * TT + 64 * n;
    const int cgp = tid % 48, tg = tid / 48, part = cgp >> 4, c8 = cgp & 15, gcol = part * 512 + 128 * h + 8 * c8;
    const bf16* QKV = (const bf16*)(a.ws + WS_QKV);
#pragma unroll
    for (int r = 0; r < 11; ++r) { const int t = 8 * tg - 3 + r; xr[r] = (u32x4){0u, 0u, 0u, 0u};
        if (t >= 0 || n > 0) xr[r] = *(const u32x4*)(QKV + (size_t)(m0 + t) * QKVD + gcol); }
}
__device__ __forceinline__ void delta_local_item(const Args& a, LAS unsigned char* lds, int l, int b, int h, int n, u32x4 (&xr)[11], int it_next) {
    const int tid = ltid(), lane = tid & 63, wave = tid >> 6;
    constexpr int FS = 144, AS = 80;
    LAS float* Ff = (LAS float*)lds;
    LAS bf16* Qb = (LAS bf16*)(lds + 110592);
    LAS bf16* Kb = (LAS bf16*)(lds + 128000);
    LAS float* AMt = (LAS float*)lds;
    LAS float* AIt = (LAS float*)(lds + 20480);
    LAS float* gc = (LAS float*)(lds + 145408);
    LAS float* bt = gc + 64;
    LAS float* rn = bt + 64;
    const bf16* QKV = (const bf16*)(a.ws + WS_QKV); const float* BG = (const float*)(a.ws + WS_BG);
    const int m0 = b * TT + 64 * n, ci = (b * 4 + h) * 32 + n;
    if (tid < 384) { const int cgp = tid % 48, tg = tid / 48, part = cgp >> 4, c8 = cgp & 15, gcol = part * 512 + 128 * h + 8 * c8;
        const float* cw = a.in[16] + (size_t)l * 4 * QKVD + gcol;
        float w[4][8];
#pragma unroll
        for (int j = 0; j < 4; ++j) { const f32x4 w0 = *(const f32x4*)(cw + j * QKVD), w1 = *(const f32x4*)(cw + j * QKVD + 4);
#pragma unroll
            for (int e = 0; e < 4; ++e) { w[j][e] = w0[e]; w[j][4 + e] = w1[e]; } }
        LAS float* dst = Ff + (part * 64 + 8 * tg) * FS + 8 * c8;
#pragma unroll
        for (int tt = 0; tt < 8; ++tt) { float y[8];
#pragma unroll
            for (int e = 0; e < 8; ++e) { float s = 0.f;
#pragma unroll
                for (int j = 0; j < 4; ++j) { const unsigned xw = xr[tt + j][e >> 1]; const float xf = (e & 1) ? __uint_as_float(xw & 0xffff0000u) : __uint_as_float(xw << 16); s += w[j][e] * xf; }
                y[e] = silu(s); }
            *(LAS f32x4*)(dst + tt * FS) = (f32x4){y[0], y[1], y[2], y[3]}; *(LAS f32x4*)(dst + tt * FS + 4) = (f32x4){y[4], y[5], y[6], y[7]}; }
        if (n == 31 && tg == 7) { float* o = a.out + OUT_SHORT_P + (size_t)((l * 8 + b) * 3) * QKVD + gcol;
#pragma unroll
            for (int r = 0; r < 3; ++r) { const u32x4 x = xr[8 + r];
                *(f32x4*)(o + r * QKVD) = (f32x4){__uint_as_float(x[0] << 16), __uint_as_float(x[0] & 0xffff0000u), __uint_as_float(x[1] << 16), __uint_as_float(x[1] & 0xffff0000u)};
                *(f32x4*)(o + r * QKVD + 4) = (f32x4){__uint_as_float(x[2] << 16), __uint_as_float(x[2] & 0xffff0000u), __uint_as_float(x[3] << 16), __uint_as_float(x[3] & 0xffff0000u)}; } }
        if (it_next >= 0) delta_local_load(a, it_next, xr);
    } else if (tid >= 448) { float g = BG[(size_t)(m0 + lane) * 8 + 4 + h];
#pragma unroll
        for (int o = 1; o < 64; o <<= 1) { const float v = __shfl_up(g, o); if (lane >= o) g += v; }
        gc[lane] = g; bt[lane] = BG[(size_t)(m0 + lane) * 8 + h]; }
    LBAR();
    { const int t = tid >> 3, cs = tid & 7;
        f32x4 q4[4], k4[4]; float sq = 0.f, sk = 0.f;
#pragma unroll
        for (int c4 = 0; c4 < 4; ++c4) { const int cc = cs * 16 + c4 * 4; q4[c4] = *(LAS f32x4*)(Ff + t * FS + cc); k4[c4] = *(LAS f32x4*)(Ff + (64 + t) * FS + cc);
            sq += (q4[c4][0] * q4[c4][0] + q4[c4][1] * q4[c4][1]) + (q4[c4][2] * q4[c4][2] + q4[c4][3] * q4[c4][3]);
            sk += (k4[c4][0] * k4[c4][0] + k4[c4][1] * k4[c4][1]) + (k4[c4][2] * k4[c4][2] + k4[c4][3] * k4[c4][3]); }
        sq = oct_sum(sq); sk = oct_sum(sk);
        const float rq = rsqrtf(sq + 1e-6f) * 0.08838834764831845f, rk = rsqrtf(sk + 1e-6f), eg = __expf(gc[t]);
        bf16* qg = (bf16*)(a.ws + WS_DQG) + (size_t)ci * 8192 + t * 128 + cs * 16;
#pragma unroll
        for (int c4 = 0; c4 < 4; ++c4) { const int cc = cs * 16 + c4 * 4;
            f32x4 q = q4[c4] * rq; const f32x4 k = k4[c4] * rk;
            *(LAS f32x4*)(Ff + (64 + t) * FS + cc) = k;
            u32x2 qb; qb.x = pk2(q[0], q[1]); qb.y = pk2(q[2], q[3]); *(LAS u32x2*)(Qb + t * 136 + cc) = qb;
            u32x2 kb; kb.x = pk2(k[0], k[1]); kb.y = pk2(k[2], k[3]); *(LAS u32x2*)(Kb + t * 136 + cc) = kb;
            q = q * eg; u32x2 qo; qo.x = pk2(q[0], q[1]); qo.y = pk2(q[2], q[3]); *(u32x2*)(qg + c4 * 4) = qo; } }
    LBAR();
    { const int k = tid >> 2, tq = tid & 3; const float gl = gc[63]; unsigned o[8];
#pragma unroll
        for (int j = 0; j < 8; ++j) { const int t0 = 16 * tq + 2 * j;
            o[j] = pk2(Ff[(64 + t0) * FS + k] * __expf(gl - gc[t0]), Ff[(64 + t0 + 1) * FS + k] * __expf(gl - gc[t0 + 1])); }
        bf16* dst = (bf16*)(a.ws + WS_DKDT) + (size_t)ci * 8192 + k * 64 + 16 * tq;
        *(u32x4*)dst = (u32x4){o[0], o[1], o[2], o[3]}; *(u32x4*)(dst + 8) = (u32x4){o[4], o[5], o[6], o[7]};
        if (tid == 0) ((float*)(a.ws + WS_EGL))[ci] = __expf(gl); }
    { const int fr = lane & 15, fq = lane >> 4, ti = wave & 3; const bool isq = wave >= 4;
        const LAS bf16* Ab = (isq ? Qb : Kb) + (16 * ti + fr) * 136 + 8 * fq;
        bf16x8 af[4];
#pragma unroll
        for (int ks = 0; ks < 4; ++ks) af[ks] = *(const LAS bf16x8*)(Ab + 32 * ks);
        bf16* qkd = (bf16*)(a.ws + WS_DQKD) + (size_t)ci * 4096;
#pragma unroll
        for (int tj = 0; tj < 4; ++tj) { f32x4 acc = (f32x4){0.f, 0.f, 0.f, 0.f};
#pragma unroll
            for (int ks = 0; ks < 4; ++ks) { const bf16x8 bfr = *(const LAS bf16x8*)(Kb + (16 * tj + fr) * 136 + 32 * ks + 8 * fq); acc = __builtin_amdgcn_mfma_f32_16x16x32_bf16(af[ks], bfr, acc, 0, 0, 0); }
            const int j = 16 * tj + fr; const float gj = gc[j];
            f32x4 am;
#pragma unroll
            for (int e = 0; e < 4; ++e) { const int i = 16 * ti + 4 * fq + e; const float dec = __expf(fminf(gc[i] - gj, 0.f));
                if (isq) qkd[i * 64 + j] = (bf16)f2bf(j <= i ? acc[e] * dec : 0.f);
                am[e] = (j < i) ? bt[i] * acc[e] * dec : 0.f; }
            if (!isq) *(LAS f32x4*)(AMt + j * AS + 16 * ti + 4 * fq) = am; }
        if (!isq && lane < 16) { const int c = lane, i0 = 16 * ti; float r[16];
#pragma unroll
            for (int ii = 0; ii < 16; ++ii) r[ii] = (ii == c) ? 1.f : 0.f;
#pragma unroll
            for (int jj = 0; jj < 15; ++jj) {
#pragma unroll
                for (int ii = jj + 1; ii < 16; ++ii) r[ii] -= AMt[(i0 + jj) * AS + i0 + ii] * r[jj]; }
            LAS float* o = AIt + ti * 256 + c * 16;
#pragma unroll
            for (int q = 0; q < 4; ++q) *(LAS f32x4*)(o + 4 * q) = (f32x4){r[4 * q], r[4 * q + 1], r[4 * q + 2], r[4 * q + 3]}; } }
    LBAR();
    { const int fr = lane & 15, fq = lane >> 4; const bool isw = wave >= 4;
        LAS float* Fx = Ff + (isw ? 64 : 128) * FS + 32 * (wave & 3) + fr;
        float* du = (float*)(a.ws + WS_DU) + (size_t)ci * 8192 + 32 * (wave & 3) + fr; bf16* dw = (bf16*)(a.ws + WS_DW) + (size_t)ci * 8192 + 32 * (wave & 3) + fr;
#pragma unroll
        for (int i = 0; i < 4; ++i) { const int i0 = 16 * i;
            f32x4 acc[2];
#pragma unroll
            for (int e = 0; e < 4; ++e) { const int row = i0 + 4 * fq + e; float sc = bt[row]; if (isw) sc *= __expf(gc[row]);
                acc[0][e] = Fx[row * FS] * sc; acc[1][e] = Fx[row * FS + 16] * sc; }
#pragma unroll
            for (int j = 0; j < i; ++j)
#pragma unroll
                for (int s = 0; s < 4; ++s) { const int kk = 16 * j + 4 * s + fq; const float av = -AMt[kk * AS + i0 + fr];
                    acc[0] = __builtin_amdgcn_mfma_f32_16x16x4f32(av, Fx[kk * FS], acc[0], 0, 0, 0);
                    acc[1] = __builtin_amdgcn_mfma_f32_16x16x4f32(av, Fx[kk * FS + 16], acc[1], 0, 0, 0); }
#pragma unroll
            for (int e = 0; e < 4; ++e) { const int row = i0 + 4 * fq + e; Fx[row * FS] = acc[0][e]; Fx[row * FS + 16] = acc[1][e]; }
            f32x4 x[2] = {(f32x4){0.f, 0.f, 0.f, 0.f}, (f32x4){0.f, 0.f, 0.f, 0.f}};
#pragma unroll
            for (int s = 0; s < 4; ++s) { const int kk = 4 * s + fq; const float av = AIt[i * 256 + kk * 16 + fr];
                x[0] = __builtin_amdgcn_mfma_f32_16x16x4f32(av, Fx[(i0 + kk) * FS], x[0], 0, 0, 0);
                x[1] = __builtin_amdgcn_mfma_f32_16x16x4f32(av, Fx[(i0 + kk) * FS + 16], x[1], 0, 0, 0); }
#pragma unroll
            for (int e = 0; e < 4; ++e) { const int row = i0 + 4 * fq + e; Fx[row * FS] = x[0][e]; Fx[row * FS + 16] = x[1][e];
                if (isw) { dw[row * 128] = (bf16)f2bf(x[0][e]); dw[row * 128 + 16] = (bf16)f2bf(x[1][e]); }
                else { du[row * 128] = x[0][e]; du[row * 128 + 16] = x[1][e]; } } } }
    LBAR();
}
__device__ __forceinline__ void phase_c1(const Args& a, LAS unsigned char* lds, int l) {
#ifndef C1REP_D
#define C1REP_D 1
#endif
#ifndef C1REP_C
#define C1REP_C 1
#endif
    for (int rr = 0; rr < C1REP_D; ++rr)
    { u32x4 xr[11]; int it = lbid(); const int G = (int)gridDim.x;
#pragma unroll
      for (int r = 0; r < 11; ++r) xr[r] = (u32x4){0u, 0u, 0u, 0u};
      if (it < 1024) delta_local_load(a, it, xr);
#pragma unroll 1
      for (; it < 1024; it += G) delta_local_item(a, lds, l, it >> 7, (it >> 5) & 3, it & 31, xr, it + G < 1024 ? it + G : -1); }
}
__device__ __forceinline__ void conv_items(const Args& a, LAS unsigned char* lds, int l, int ob, int OG, bool with_sample) {
    for (int it = ob; it < 256 + (with_sample ? 128 : 0); it += OG) {
        if (it < 256) conv_prompt_item(a, lds, l, it >> 5, it & 31);
        else conv_sample_item(a, lds, l, it - 256);
    }
}

template <int NT, int MODE = 0>
__device__ __forceinline__ void delta_seq_item(const Args& a, LAS unsigned char* lds, int l, int it) {
    const int tid = ltid(), lane = tid & 63, w = tid >> 6, fr = lane & 15, fq = lane >> 4, rb = w & 3;
    constexpr int NVS = 8 / NT, VW = 16 * NT; const int bh = it / NVS, vs = it % NVS, b = bh >> 2, h = bh & 3;
    LAS bf16* St = (LAS bf16*)lds;
    LAS bf16* VNt = St + VW * 136;
    for (int i = tid; i < VW * 136 / 2; i += 512) ((LAS unsigned*)St)[i] = 0u;
    LBAR();
    const bf16* DW = (const bf16*)(a.ws + WS_DW); const bf16* DQG = (const bf16*)(a.ws + WS_DQG); const bf16* DKDT = (const bf16*)(a.ws + WS_DKDT);
    const bf16* DQKD = (const bf16*)(a.ws + WS_DQKD); const float* DU = (const float*)(a.ws + WS_DU); const float* EGL = (const float*)(a.ws + WS_EGL);
    float* O = (float*)(a.ws + WS_O);
    f32x4 Sacc[NT];
#pragma unroll
    for (int t = 0; t < NT; ++t) Sacc[t] = (f32x4){0.f, 0.f, 0.f, 0.f};
    const bool lead = w < 4;
#define WGBAR() do { if (MODE != 1) { asm volatile("s_waitcnt lgkmcnt(0)" ::: "memory"); __builtin_amdgcn_s_barrier(); asm volatile("" ::: "memory"); } } while (0)
    int vz = 0; asm volatile("" : "+v"(vz));
    struct ChunkOps { bf16x8 af[4], kd[2], qd[2]; float uu[NT][4], egl; };
#define D1_LOAD(B, n_) do { if (MODE == 2 && (n_) >= 4) break; const size_t ci_ = (size_t)bh * 32 + ((n_) < 32 ? (n_) : 31); \
        const bf16* Aop_ = (lead ? DW : DQG) + ci_ * 8192 + (16 * rb + fr) * 128 + 8 * fq; \
        _Pragma("unroll") for (int ks = 0; ks < 4; ++ks) B.af[ks] = *(const bf16x8*)(Aop_ + 32 * ks); \
        _Pragma("unroll") for (int k2 = 0; k2 < 2; ++k2) B.kd[k2] = *(const bf16x8*)(DKDT + ci_ * 8192 + (16 * w + fr) * 64 + 32 * k2 + 8 * fq); \
        if (lead) { _Pragma("unroll") for (int t = 0; t < NT; ++t) _Pragma("unroll") for (int e = 0; e < 4; ++e) B.uu[t][e] = DU[ci_ * 8192 + (16 * rb + 4 * fq + e) * 128 + VW * vs + 16 * t + fr]; } \
        else { _Pragma("unroll") for (int k2 = 0; k2 < 2; ++k2) B.qd[k2] = *(const bf16x8*)(DQKD + ci_ * 4096 + (16 * rb + fr) * 64 + 32 * k2 + 8 * fq); } \
        B.egl = EGL[ci_ + vz]; } while (0)
#define D1_INIT(B) do { _Pragma("unroll") for (int t = 0; t < NT; ++t) _Pragma("unroll") for (int e = 0; e < 4; ++e) B.uu[t][e] = 0.f; B.qd[0] = B.qd[1] = (bf16x8){0, 0, 0, 0, 0, 0, 0, 0}; } while (0)
#define D1_STEP(B, n_) do { \
        f32x4 acc[NT]; _Pragma("unroll") for (int t = 0; t < NT; ++t) acc[t] = (f32x4){0.f, 0.f, 0.f, 0.f}; \
        _Pragma("unroll") for (int ks = 0; ks < 4; ++ks) _Pragma("unroll") for (int t = 0; t < NT; ++t) { \
            const bf16x8 bfr = *(const LAS bf16x8*)(St + (16 * t + fr) * 136 + 32 * ks + 8 * fq); acc[t] = __builtin_amdgcn_mfma_f32_16x16x32_bf16(B.af[ks], bfr, acc[t], 0, 0, 0); } \
        if (lead) { _Pragma("unroll") for (int t = 0; t < NT; ++t) { u32x2 o; o.x = pk2(B.uu[t][0] - acc[t][0], B.uu[t][1] - acc[t][1]); o.y = pk2(B.uu[t][2] - acc[t][2], B.uu[t][3] - acc[t][3]); \
            *(LAS u32x2*)(VNt + (16 * t + fr) * 72 + 16 * rb + 4 * fq) = o; } } \
        WGBAR(); \
        bf16x8 bv[NT][2]; \
        _Pragma("unroll") for (int t = 0; t < NT; ++t) _Pragma("unroll") for (int k2 = 0; k2 < 2; ++k2) bv[t][k2] = *(const LAS bf16x8*)(VNt + (16 * t + fr) * 72 + 32 * k2 + 8 * fq); \
        if (!lead) { \
            _Pragma("unroll") for (int t = 0; t < NT; ++t) { \
                _Pragma("unroll") for (int k2 = 0; k2 < 2; ++k2) acc[t] = __builtin_amdgcn_mfma_f32_16x16x32_bf16(B.qd[k2], bv[t][k2], acc[t], 0, 0, 0); \
                float* op = O + (size_t)(b * TT + 64 * (n_) + 16 * rb + 4 * fq) * CC + 128 * h + VW * vs + 16 * t + fr; \
                _Pragma("unroll") for (int e = 0; e < 4; ++e) op[(size_t)e * CC] = acc[t][e]; } \
        } \
        _Pragma("unroll") for (int t = 0; t < NT; ++t) { Sacc[t] = Sacc[t] * B.egl; \
            _Pragma("unroll") for (int k2 = 0; k2 < 2; ++k2) Sacc[t] = __builtin_amdgcn_mfma_f32_16x16x32_bf16(B.kd[k2], bv[t][k2], Sacc[t], 0, 0, 0); \
            u32x2 o; o.x = pk2(Sacc[t][0], Sacc[t][1]); o.y = pk2(Sacc[t][2], Sacc[t][3]); *(LAS u32x2*)(St + (16 * t + fr) * 136 + 16 * w + 4 * fq) = o; } \
        WGBAR(); } while (0)
    ChunkOps B0, B1, B2, B3;
    D1_INIT(B0); D1_INIT(B1); D1_INIT(B2); D1_INIT(B3);
    D1_LOAD(B0, 0); D1_LOAD(B1, 1); D1_LOAD(B2, 2); D1_LOAD(B3, 3);
#pragma unroll 1
    for (int n = 0; n < 32; n += 4) {
        D1_STEP(B0, n);     D1_LOAD(B0, n + 4);
        D1_STEP(B1, n + 1); D1_LOAD(B1, n + 5);
        D1_STEP(B2, n + 2); D1_LOAD(B2, n + 6);
        D1_STEP(B3, n + 3); D1_LOAD(B3, n + 7);
    }
#undef D1_LOAD
#undef D1_INIT
#undef D1_STEP
#pragma unroll
    for (int t = 0; t < NT; ++t) { float* so = a.out + OUT_DELTA_P + ((size_t)((l * 8 + b) * 4 + h) * 128 + 16 * w + 4 * fq) * 128 + VW * vs + 16 * t + fr;
#pragma unroll
        for (int e = 0; e < 4; ++e) so[(size_t)e * 128] = Sacc[t][e]; }
    LBAR();
}
__device__ __forceinline__ void delta_sample_item(const Args& a, LAS unsigned char* lds, int l, int s, int h) {
    const int tid = ltid(), lane = tid & 63, wave = tid >> 6;
    LAS float* qkv = (LAS float*)lds;
    LAS float* misc = qkv + 384;
    LAS float* vnew = misc + 16;
    LAS float* PK = vnew + 128;
    LAS float* PQ = PK + 2048;
    const int kg = tid >> 5, c4 = tid & 31;
    const size_t sbase = ((size_t)((l * MS + s) * 4 + h) * 128) * 128;
    const float* Sin = a.in[6] + sbase;
    f32x4 Sr[8];
#pragma unroll
    for (int r = 0; r < 8; ++r) Sr[r] = __builtin_nontemporal_load((const f32x4*)(Sin + (size_t)(kg * 8 + r) * 128 + 4 * c4));
    if (tid < 384) { const int part = tid >> 7, col = tid & 127, gcol = part * 512 + 128 * h + col;
        const float* cw = a.in[16] + (size_t)l * 4 * QKVD + gcol; const float* st = a.in[5] + (size_t)((l * MS + s) * 3) * QKVD + gcol;
        const float x0 = st[0], x1 = st[QKVD], x2 = st[2 * QKVD], x3 = bf2f(((const bf16*)(a.ws + WS_QKV))[(size_t)(MP + s) * QKVD + gcol]);
        qkv[tid] = silu(cw[0] * x0 + cw[QKVD] * x1 + cw[2 * QKVD] * x2 + cw[3 * QKVD] * x3);
        float* o = a.out + OUT_SHORT_S + (size_t)((l * MS + s) * 3) * QKVD + gcol; o[0] = x1; o[QKVD] = x2; o[2 * QKVD] = x3; }
    LBAR();
    float rq, rk, qk;
    { const float q0 = qkv[lane], q1 = qkv[lane + 64], k0 = qkv[128 + lane], k1 = qkv[192 + lane];
        const float qq = wave_sum(q0 * q0 + q1 * q1), kk = wave_sum(k0 * k0 + k1 * k1), qkr = wave_sum(q0 * k0 + q1 * k1);
        rq = rsqrtf(qq + 1e-6f) * 0.08838834764831845f; rk = rsqrtf(kk + 1e-6f); qk = qkr * rq * rk; }
    const float* BG = (const float*)(a.ws + WS_BG);
    const float beta = BG[(size_t)(MP + s) * 8 + h], eg = __expf(BG[(size_t)(MP + s) * 8 + 4 + h]);
    f32x4 pk = (f32x4){0.f, 0.f, 0.f, 0.f}, pq = pk;
#pragma unroll
    for (int r = 0; r < 8; ++r) { const float kv = qkv[128 + kg * 8 + r] * rk, qv = qkv[kg * 8 + r] * rq; pk += Sr[r] * kv; pq += Sr[r] * qv; }
    *(LAS f32x4*)(PK + kg * 128 + 4 * c4) = pk; *(LAS f32x4*)(PQ + kg * 128 + 4 * c4) = pq;
    LBAR();
    if (tid < 128) { float kS = 0.f, qS = 0.f;
#pragma unroll
        for (int g = 0; g < 16; ++g) { kS += PK[g * 128 + tid]; qS += PQ[g * 128 + tid]; }
        const float vn = beta * (qkv[256 + tid] - eg * kS);
        ((float*)(a.ws + WS_O))[(size_t)(MP + s) * CC + 128 * h + tid] = eg * qS + qk * vn;
        vnew[tid] = vn; }
    LBAR();
    const f32x4 vn4 = *(const LAS f32x4*)(vnew + 4 * c4);
    float* So = a.out + OUT_DELTA_S + sbase;
#pragma unroll
    for (int r = 0; r < 8; ++r) { const float kv = qkv[128 + kg * 8 + r] * rk; __builtin_nontemporal_store(Sr[r] * eg + vn4 * kv, (f32x4*)(So + (size_t)(kg * 8 + r) * 128 + 4 * c4)); }
    LBAR();
}
__device__ __forceinline__ void phase_e1(const Args& a, int l) {
    const int tid = ltid(), lane = tid & 63, wave = tid >> 6;
    const int gw = lbid() * 8 + wave, NGW = gridDim.x * 8;
    const float* O = (const float*)(a.ws + WS_O); const bf16* ZS = (const bf16*)(a.ws + WS_ZS); bf16* OB = (bf16*)(a.ws + WS_OB);
    const float* gn = a.in[19] + l * HD + 8 * (lane & 15);
    const f32x4 g0 = *(const f32x4*)gn, g1 = *(const f32x4*)(gn + 4);
    f32x4 p0[2], p1[2]; u32x4 pz[2];
#pragma unroll
    for (int q = 0; q < 2; ++q) { const int mm = gw + q * NGW;
        if (mm < MV) { p0[q] = __builtin_nontemporal_load((const f32x4*)(O + (size_t)mm * CC + 8 * lane)); p1[q] = __builtin_nontemporal_load((const f32x4*)(O + (size_t)mm * CC + 8 * lane + 4)); pz[q] = __builtin_nontemporal_load((const u32x4*)(ZS + (size_t)mm * CC + 8 * lane)); } }
    for (int m = gw; m < MV; m += NGW) {
        const f32x4 o0 = p0[0], o1 = p1[0]; const u32x4 z = pz[0];
        p0[0] = p0[1]; p1[0] = p1[1]; pz[0] = pz[1];
        { const int mm = m + 2 * NGW; if (mm < MV) { p0[1] = __builtin_nontemporal_load((const f32x4*)(O + (size_t)mm * CC + 8 * lane)); p1[1] = __builtin_nontemporal_load((const f32x4*)(O + (size_t)mm * CC + 8 * lane + 4)); pz[1] = __builtin_nontemporal_load((const u32x4*)(ZS + (size_t)mm * CC + 8 * lane)); } }
        float ss = (o0[0] * o0[0] + o0[1] * o0[1]) + (o0[2] * o0[2] + o0[3] * o0[3]) + (o1[0] * o1[0] + o1[1] * o1[1]) + (o1[2] * o1[2] + o1[3] * o1[3]);
        ss = row16_sum(ss);
        const float r = rsqrtf(ss * (1.f / HD) + 1e-6f);
        float v[8];
#pragma unroll
        for (int j = 0; j < 8; ++j) { const unsigned zw = z[j >> 1]; const float zf = (j & 1) ? __uint_as_float(zw & 0xffff0000u) : __uint_as_float(zw << 16);
            v[j] = (j < 4 ? o0[j] * g0[j] : o1[j - 4] * g1[j - 4]) * r * zf; }
        u32x4 w; w.x = pk2(v[0], v[1]); w.y = pk2(v[2], v[3]); w.z = pk2(v[4], v[5]); w.w = pk2(v[6], v[7]);
        *(u32x4*)(OB + (size_t)m * CC + 8 * lane) = w;
    }
}

__global__ void __launch_bounds__(512, 2) mega(Args a0) {
    extern __shared__ __attribute__((aligned(16))) unsigned char lds_raw[];
    LAS unsigned char* lds = (LAS unsigned char*)lds_raw;
    cg::grid_group grid = cg::this_grid();
    volatile LAS unsigned* bst = (volatile LAS unsigned*)(lds + LDS_BYTES - 64);
    if (threadIdx.x < 2) bst[threadIdx.x] = 0u;
    __syncthreads();
    XcdBarrier xbar = xcd_barrier_post((unsigned*)(a0.ws + 16384), bst);
    for (int ph = a0.ph_lo; ph < a0.ph_hi; ++ph) {
        size_t zoff = 0; asm volatile("" : "+s"(zoff));
        Args a = a0; a.ws = a0.ws + zoff; a.out = a0.out + zoff;
#ifndef REPMASK
#define REPMASK 0
#endif
        const int ptype = ph == 0 ? 10 : ph == 1 ? 11 : ph == NPH - 1 ? 12 : (ph - 2) % 10;
        const int nrep = 1 + ((REPMASK >> ptype) & 1);
        for (int rep = 0; rep < nrep; ++rep) {
        if (rep > 0) xcd_barrier(xbar);
#ifndef PHMASK
#define PHMASK 0xFFFF
#endif
#define HAS(x) ((PHMASK >> (x)) & 1)
        if (ph == 0) { if (HAS(10)) phase_p0a(a, lds); }
        else if (ph == 1) { if (HAS(11)) { EpiMod E{(float*)(a.ws + WS_MOD), a.in[8]}; run_gemm(lds, (const bf16*)(a.ws + WS_SC), (const bf16*)(a.ws + WS_WADA), 256, MODLD, 1024, E);
            { const int G = (int)gridDim.x, nu = MODLD / 256, bid = lbid();
              if (G > nu) { if (bid >= nu) convert_layer(a, lds, 0, (bid - nu) * 8 + (ltid() >> 6), (G - nu) * 8); }
              else convert_layer(a, lds, 0, bid * 8 + (ltid() >> 6), G * 8); } } }
        else if (ph == NPH - 1) { if (HAS(12)) phase_final(a); }
        else {
            const int l = (ph - 2) / 10, j = (ph - 2) % 10;
            unsigned char* lw = a.ws + WS_W + (size_t)l * LW_SZ;
            const float* MODl = (const float*)(a.ws + WS_MOD) + (size_t)l * NMOD;
            switch (j) {
            case 0: if (HAS(0)) phase_norm<0>(a, lds, l); break;
            case 1: if (HAS(1)) { EpiIn E{(bf16*)(a.ws + WS_U), (bf16*)(a.ws + WS_QKV), (bf16*)(a.ws + WS_ZS), (bf16*)(a.ws + WS_MA), (bf16*)(a.ws + WS_MB)};
                run_gemm(lds, (const bf16*)(a.ws + WS_H), (const bf16*)(lw + LW_IN), MP, NIN, 1024, E);
                { SkInAll E1{E.U, E.QKV, E.ZS, E.MA, E.MB}; splitk_units<2, 5>(lds, (const bf16*)(a.ws + WS_H) + (size_t)MP * 1024, (const bf16*)(lw + LW_IN), 1024, 64, E1); } } break;
            case 2: if (HAS(2)) phase_c1(a, lds, l); break;
            case 3: if (HAS(3)) {
                const int bidx = lbid(), G = (int)gridDim.x; int ob = bidx, OG = G; bool with_sample = (G != 256);
#ifndef D1_NT
#define D1_NT 2
#endif
                constexpr int NVS = 8 / D1_NT, NSB = 4 * NVS;
                if (G == 256) { const int x = bidx & 7, j = bidx >> 3;
#ifdef D1EXP
                    if (j < NSB) delta_seq_item<D1_NT, D1EXP>(a, lds, l, (4 * x + j / NVS) * NVS + (j % NVS));
#endif
                    if (j < NSB) { delta_seq_item<D1_NT>(a, lds, l, (4 * x + j / NVS) * NVS + (j % NVS)); ob = -1;
                        for (int s = x + 8 * j; s < 128; s += 8 * NSB) conv_sample_item(a, lds, l, s); with_sample = false; }
                    else { ob = x + 8 * (j - NSB); OG = 256 - 8 * NSB; } }
                else { for (int it = bidx; it < 32 * NVS; it += G) delta_seq_item<D1_NT>(a, lds, l, it); }
                if (ob >= 0) {
                    for (int it = ob; it < 512; it += OG) delta_sample_item(a, lds, l, it >> 2, it & 3);
                    conv_items(a, lds, l, ob, OG, with_sample);
                }
                } break;
            case 4: if (HAS(4)) phase_e1(a, l); break;
            case 5: if (HAS(5)) { EpiMerge E{(const bf16*)(a.ws + WS_MA), (const bf16*)(a.ws + WS_MB), (bf16*)(a.ws + WS_MG)};
                { pg8::Gemm g{(const bf16*)(a.ws + WS_OB), (const bf16*)(lw + LW_D), MP, D, 512, (long)WS_CA - (long)WS_OB, (long)LW_C - (long)LW_D};
                  pg8::TwoSegOrder S; S.init(MP, D, (int)gridDim.x, lbid()); pg8::gemm_phase<EpiMerge, pg8::TwoSegOrder, true, true>(lds, g, S, E); }
                { SkGate<false> E1{E.SA, nullptr, (bf16*)(a.ws + WS_Y)}; splitk_units<1, 2>(lds, (const bf16*)(a.ws + WS_CA) + (size_t)MP * 512, (const bf16*)(lw + LW_C), 512, 32, E1);
                  SkGate<true> E2{E.SB, (const bf16*)(a.ws + WS_Y), E.Out}; splitk_units<1, 2>(lds, (const bf16*)(a.ws + WS_OB) + (size_t)MP * 512, (const bf16*)(lw + LW_D), 512, 32, E2); } } break;
            case 6: if (HAS(6)) { EpiRes E{a.in[0], a.in[1], (const float*)(a.ws + WS_X), (float*)(a.ws + WS_X), MODl + 2 * D, l == 0 ? 1 : 0};
                run_gemm(lds, (const bf16*)(a.ws + WS_MG), (const bf16*)(lw + LW_M), MP, D, 1024, E);
                { SkRes E1{a.in[1], E.Xin, E.Xout, E.gt, E.use_in}; splitk_units<1, 2>(lds, (const bf16*)(a.ws + WS_MG) + (size_t)MP * 1024, (const bf16*)(lw + LW_M), 1024, 32, E1); } } break;
            case 7: if (HAS(7)) phase_norm<1>(a, lds, l); break;
            case 8: if (HAS(8)) { EpiSwi E{(bf16*)(a.ws + WS_HH)};
                run_gemm(lds, (const bf16*)(a.ws + WS_H), (const bf16*)(lw + LW_F1), MT, NF1, 1024, E);
                if (l + 1 < NL) {
                    const int G = (int)gridDim.x, nu = (MT / 256) * (NF1 / 256), first = (nu % G) ? (nu % G) : 0, nb = G - first, bid = lbid();
                    if (bid >= first) convert_layer(a, lds, l + 1, (bid - first) * 8 + (ltid() >> 6), nb * 8); } } break;
            default: if (HAS(9)) { EpiRes E{a.in[0], a.in[1], (const float*)(a.ws + WS_X), (float*)(a.ws + WS_X), MODl + 5 * D, 0};
                run_gemm(lds, (const bf16*)(a.ws + WS_HH), (const bf16*)(lw + LW_F2), MP, D, DFF, E);
                { SkRes E1{a.in[1], E.Xin, E.Xout, E.gt, 0}; splitk_units<1, 2, 6>(lds, (const bf16*)(a.ws + WS_HH) + (size_t)MP * DFF, (const bf16*)(lw + LW_F2), DFF, 32, E1); } } break;
            }
        }
        }
        if (ph + 1 < a0.ph_hi) { if (a0.ph_lo < 0) { __threadfence(); grid.sync(); }
            else { xcd_barrier(xbar);
#ifdef BARREP
            xcd_barrier(xbar);
#endif
        } }
    }
}

extern "C" void kernel_launch(void* const* d_in, const int* in_sizes, int n_in, void* d_out, int out_size, void* d_ws, size_t ws_size, hipStream_t stream) {
    static int grid = 0;
    if (grid == 0) {
        if (n_in != 26 || ws_size < WS_END || out_size != 63422464) { fprintf(stderr, "kernel_launch: unexpected problem: n_in %d ws %zu out %d\n", n_in, ws_size, out_size); grid = -1; return; }
        int dev = 0, cus = 0, per_cu = 0;
        if (hipGetDevice(&dev) != hipSuccess || hipDeviceGetAttribute(&cus, hipDeviceAttributeMultiprocessorCount, dev) != hipSuccess) { grid = -1; return; }
        if (hipFuncSetAttribute((const void*)mega, hipFuncAttributeMaxDynamicSharedMemorySize, LDS_BYTES) != hipSuccess) { fprintf(stderr, "kernel_launch: hipFuncSetAttribute failed\n"); grid = -1; return; }
        if (hipOccupancyMaxActiveBlocksPerMultiprocessor(&per_cu, (const void*)mega, 512, LDS_BYTES) != hipSuccess || per_cu < 1) { fprintf(stderr, "kernel_launch: occupancy query says %d\n", per_cu); per_cu = 1; }
        (void)hipGetLastError();
        grid = cus * (per_cu > 1 ? 1 : per_cu);
    }
    if (grid < 0) return;
    Args a{};
    for (int i = 0; i < 26; ++i) a.in[i] = (const float*)d_in[i];
    a.out = (float*)d_out; a.ws = (unsigned char*)d_ws;
#if MK_ONE_LAUNCH
    if (hipMemsetAsync(d_ws, 0, 65536, stream) != hipSuccess) { fprintf(stderr, "kernel_launch: memset failed\n"); return; }
    a.ph_lo = 0; a.ph_hi = NPH;
    void* args[] = {&a};
    hipError_t e = hipLaunchCooperativeKernel((const void*)mega, dim3(grid), dim3(512), args, LDS_BYTES, stream);
    if (e != hipSuccess) fprintf(stderr, "cooperative launch failed: %s (grid %d)\n", hipGetErrorString(e), grid);
#else
    for (int ph = 0; ph < NPH; ++ph) { a.ph_lo = ph; a.ph_hi = ph + 1; hipLaunchKernelGGL(mega, dim3(grid), dim3(512), LDS_BYTES, stream, a); }
#endif
}
```

```cpp
#include <hip/hip_runtime.h>
#include <hip/hip_cooperative_groups.h>
#include <cstdio>
#include <cstdint>
namespace cg = cooperative_groups;
__device__ __forceinline__ int pg8_ltid() { int t = threadIdx.x; asm volatile("" : "+v"(t)); return t; }
namespace pg8 {
#define PG8_LAS __attribute__((address_space(3)))
typedef unsigned short bf16_t;
typedef short bf16x8 __attribute__((ext_vector_type(8)));
typedef float f32x4 __attribute__((ext_vector_type(4)));
typedef unsigned u32x4 __attribute__((ext_vector_type(4)));
constexpr int BM = 256, BK = 64, HALF = 128, HTB = HALF * BK * 2  , STAGE_BYTES = 8 * HTB, NXCD = 8, WGM = 8;

__host__ __device__ __forceinline__ int lds_byte(int r, int c) { const int st = (r >> 4) * 2 + (c >> 5), rr = r & 15, cc = c & 31, ob = rr * 64 + cc * 2; return st * 1024 + (ob ^ (((ob >> 9) & 1) << 5)); }
__host__ __device__ __forceinline__ void stage_rc(int b, int& R, int& C) { const int st = b / 1024, sb = b % 1024, swz = sb ^ (((sb >> 9) & 1) << 5); R = (st >> 1) * 16 + swz / 64; C = (st & 1) * 32 + (swz % 64) / 2; }
__host__ __device__ __forceinline__ int perm32(int rho) { const int n = rho >> 4, i = rho & 15; return 8 * (i >> 2) + 4 * n + (i & 3); }

struct Unit { int pm, pn, seg; };
struct Gemm { const bf16_t* A; const bf16_t* Bt; int M, N, K; long dA, dB; };

struct StaticOrder {
    int nM, nN, nwg, G, c;
    __host__ __device__ void init(int M, int N, int G_, int c_) { nM = M / BM; nN = N / BM; nwg = nM * nN; G = G_; c = c_; }
    __host__ __device__ bool next(int i, Unit& u) const {
        const long L = (long)i * G + c; if (L >= nwg) return false;
        int wgid = (int)L; { const int q = nwg / NXCD, r = nwg % NXCD, xcd = wgid % NXCD, off = wgid / NXCD; wgid = (xcd < r ? xcd * (q + 1) : r * (q + 1) + (xcd - r) * q) + off; }
        const int nig = WGM * nN, gid = wgid / nig, fm = gid * WGM, gsz = (nM - fm) < WGM ? (nM - fm) : WGM;
        u.pm = fm + ((wgid % nig) % gsz); u.pn = (wgid % nig) / gsz; u.seg = 0; return true;
    }
    __device__ __forceinline__ void a_ready(const Unit&) const {}
    __device__ __forceinline__ void done(const Unit&) const {}
};
struct TwoSegOrder : StaticOrder {
    __host__ __device__ bool next(int i, Unit& u) const { if (!StaticOrder::next(i >> 1, u)) return false; u.seg = i & 1; return true; }
};


__device__ __forceinline__ unsigned cvt_pk_bf16(float lo, float hi) { unsigned r; asm volatile("v_cvt_pk_bf16_f32 %0, %1, %2" : "=v"(r) : "v"(lo), "v"(hi)); return r; }
typedef float f32x2 __attribute__((ext_vector_type(2)));
template <class Epi, class Sched, bool ALIGN_EPI = false, bool SP2 = false>
__device__ __forceinline__ void gemm_phase(PG8_LAS unsigned char* lds, const Gemm g, const Sched& S, const Epi& E) {
    const int tid = pg8_ltid(), wid = __builtin_amdgcn_readfirstlane(tid >> 6), lane = tid & 63, wr = wid >> 2, wc = wid & 3, fr = lane & 15, fq = lane >> 4;
    const int K = g.K, nt = K / BK;
    unsigned voffA[2], voffB[2];
#pragma unroll
    for (int i = 0; i < 2; ++i) { int R, C; stage_rc(tid * 16 + i * 8192, R, C); const int Rb = Epi::PERM ? ((R & ~31) + perm32(R & 31)) : R;
        voffA[i] = (unsigned)(R * K + C) * 2u; voffB[i] = (unsigned)(Rb * K + C) * 2u; }
    const size_t kstep = (size_t)(BK * 2);
    const size_t hstep = (size_t)HALF * K * 2;
    const size_t tstep = 2 * hstep;
    const unsigned ldsw = (unsigned)wid * 1024u;
    const int aoff = lds_byte(wr * 64 + fr, fq * 8), boff = lds_byte(wc * 32 + fr, fq * 8);
#define PG8_SA(b, h) (((b) * 2 + (h)) * HTB)
#define PG8_SB(b, h) ((4 + (b) * 2 + (h)) * HTB)
#define PG8_STAGE(bufoff, gbase, voff) do { _Pragma("unroll") for (int _i = 0; _i < 2; ++_i) \
        __builtin_amdgcn_global_load_lds((const unsigned*)((const char*)(gbase) + (voff)[_i]), (PG8_LAS unsigned*)(lds + (bufoff) + ldsw + _i * 8192), 16, 0, 0); } while (0)
#define PG8_LDA(dst, b, h) do { _Pragma("unroll") for (int m = 0; m < 4; ++m) _Pragma("unroll") for (int k = 0; k < 2; ++k) dst[m][k] = *(const PG8_LAS bf16x8*)(lds + PG8_SA(b, h) + aoff + m * 2048 + k * 1024); } while (0)
#define PG8_LDB(dst, b, h) do { _Pragma("unroll") for (int n = 0; n < 2; ++n) _Pragma("unroll") for (int k = 0; k < 2; ++k) dst[n][k] = *(const PG8_LAS bf16x8*)(lds + PG8_SB(b, h) + boff + n * 2048 + k * 1024); } while (0)
#define PG8_MMA(ai, bj, At, Bt) do { __builtin_amdgcn_s_setprio(1); _Pragma("unroll") for (int m = 0; m < 4; ++m) _Pragma("unroll") for (int n = 0; n < 2; ++n) _Pragma("unroll") for (int k = 0; k < 2; ++k) \
        acc[ai][bj][m][n] = __builtin_amdgcn_mfma_f32_16x16x32_bf16(Bt[n][k], At[m][k], acc[ai][bj][m][n], 0, 0, 0); __builtin_amdgcn_s_setprio(0); } while (0)
#define PG8_WAIT_V(n) asm volatile("s_waitcnt vmcnt(" #n ")" ::: "memory")
#define PG8_WAIT_L(n) asm volatile("s_waitcnt lgkmcnt(" #n ")" ::: "memory")
#define PG8_BAR __builtin_amdgcn_s_barrier()
#define PG8_SCHED __builtin_amdgcn_sched_barrier(0)
    Unit cur, nxt; int ui = 0;
    if (!S.next(0, cur)) return;
    f32x4 acc[2][2][4][2];
#pragma unroll
    for (int a = 0; a < 2; ++a)
#pragma unroll
        for (int b = 0; b < 2; ++b)
#pragma unroll
            for (int m = 0; m < 4; ++m)
#pragma unroll
                for (int n = 0; n < 2; ++n) acc[a][b][m][n] = (f32x4){0.f, 0.f, 0.f, 0.f};
    bf16x8 At[4][2], B0[2][2], B1[2][2];
    const char* cA = (const char*)g.A + (size_t)cur.pm * tstep + (cur.seg ? g.dA : 0l); const char* cB = (const char*)g.Bt + (size_t)cur.pn * tstep + (cur.seg ? g.dB : 0l);
    S.a_ready(cur);
    if constexpr (SP2) {
        PG8_STAGE(PG8_SB(0, 0), cB, voffB); PG8_STAGE(PG8_SB(0, 1), cB + hstep, voffB); PG8_STAGE(PG8_SA(0, 0), cA, voffA); PG8_STAGE(PG8_SA(0, 1), cA + hstep, voffA);
        if (wr == 1) PG8_BAR;
        PG8_WAIT_V(2); PG8_BAR;
        PG8_STAGE(PG8_SB(1, 0), cB + kstep, voffB); PG8_STAGE(PG8_SA(1, 0), cA + kstep, voffA); PG8_STAGE(PG8_SB(1, 1), cB + hstep + kstep, voffB);
        PG8_WAIT_V(6); PG8_BAR;
    } else {
        PG8_STAGE(PG8_SB(0, 0), cB, voffB); PG8_STAGE(PG8_SA(0, 0), cA, voffA); PG8_STAGE(PG8_SB(0, 1), cB + hstep, voffB); PG8_STAGE(PG8_SA(0, 1), cA + hstep, voffA);
        if (wr == 1) PG8_BAR;
        PG8_WAIT_V(4); PG8_BAR;
        PG8_STAGE(PG8_SB(1, 0), cB + kstep, voffB); PG8_STAGE(PG8_SA(1, 0), cA + kstep, voffA); PG8_STAGE(PG8_SB(1, 1), cB + hstep + kstep, voffB);
        PG8_WAIT_V(6); PG8_BAR;
    }
    for (;;) {
        const bool has_next = S.next(ui + 1, nxt);
        const char* nA = has_next ? (const char*)g.A + (size_t)nxt.pm * tstep + (nxt.seg ? g.dA : 0l) : cA; const char* nB = has_next ? (const char*)g.Bt + (size_t)nxt.pn * tstep + (nxt.seg ? g.dB : 0l) : cB;
        for (int t = 0; t < nt; t += 2) {
            const bool last = (t == nt - 2);
            const char* a1 = cA + (size_t)(t + 1) * kstep;
            const char* a2 = last ? nA : cA + (size_t)(t + 2) * kstep; const char* b2 = last ? nB : cB + (size_t)(t + 2) * kstep;
            const char* a3 = a2 + kstep; const char* b3 = b2 + kstep;
            if (last && has_next) S.a_ready(nxt);
            if constexpr (SP2) {
            PG8_LDB(B0, 0, 0); PG8_LDB(B1, 0, 1); PG8_SCHED; PG8_LDA(At, 0, 0); PG8_STAGE(PG8_SA(1, 1), a1 + hstep, voffA);
            PG8_WAIT_V(8); PG8_WAIT_L(0); PG8_BAR; PG8_MMA(0, 0, At, B0); PG8_MMA(0, 1, At, B1); PG8_BAR; PG8_SCHED;
            PG8_LDA(At, 0, 1); PG8_STAGE(PG8_SB(0, 0), b2, voffB); PG8_STAGE(PG8_SB(0, 1), b2 + hstep, voffB); PG8_STAGE(PG8_SA(0, 0), a2, voffA);
            PG8_WAIT_V(8); PG8_WAIT_L(0); PG8_BAR; PG8_MMA(1, 0, At, B0); PG8_MMA(1, 1, At, B1); PG8_BAR; PG8_SCHED;
            PG8_LDB(B0, 1, 0); PG8_LDB(B1, 1, 1); PG8_SCHED; PG8_LDA(At, 1, 0); PG8_STAGE(PG8_SA(0, 1), a2 + hstep, voffA);
            PG8_WAIT_V(8); PG8_WAIT_L(0); PG8_BAR; PG8_MMA(0, 0, At, B0); PG8_MMA(0, 1, At, B1); PG8_BAR; PG8_SCHED;
            PG8_LDA(At, 1, 1); PG8_STAGE(PG8_SB(1, 0), b3, voffB); PG8_STAGE(PG8_SB(1, 1), b3 + hstep, voffB); PG8_STAGE(PG8_SA(1, 0), a3, voffA);
            PG8_WAIT_V(8); PG8_WAIT_L(0); PG8_BAR; PG8_MMA(1, 0, At, B0); PG8_MMA(1, 1, At, B1); PG8_BAR; PG8_SCHED;
            } else {
            PG8_LDB(B0, 0, 0); PG8_SCHED; PG8_LDA(At, 0, 0); PG8_STAGE(PG8_SA(1, 1), a1 + hstep, voffA);
            PG8_WAIT_L(8); PG8_BAR; PG8_WAIT_L(0); PG8_MMA(0, 0, At, B0); PG8_BAR; PG8_SCHED;
            PG8_LDB(B1, 0, 1); PG8_STAGE(PG8_SB(0, 0), b2, voffB);
            PG8_BAR; PG8_WAIT_L(0); PG8_MMA(0, 1, At, B1); PG8_BAR;
            PG8_LDA(At, 0, 1); PG8_STAGE(PG8_SA(0, 0), a2, voffA);
            PG8_BAR; PG8_WAIT_L(0); PG8_MMA(1, 0, At, B0); PG8_BAR; PG8_SCHED;
            PG8_STAGE(PG8_SB(0, 1), b2 + hstep, voffB);
            PG8_WAIT_V(6); PG8_BAR; PG8_MMA(1, 1, At, B1); PG8_BAR;
            PG8_LDB(B0, 1, 0); PG8_SCHED; PG8_LDA(At, 1, 0); PG8_STAGE(PG8_SA(0, 1), a2 + hstep, voffA);
            PG8_WAIT_L(8); PG8_BAR; PG8_WAIT_L(0); PG8_MMA(0, 0, At, B0); PG8_BAR; PG8_SCHED;
            PG8_LDB(B1, 1, 1); PG8_STAGE(PG8_SB(1, 0), b3, voffB);
            PG8_BAR; PG8_WAIT_L(0); PG8_MMA(0, 1, At, B1); PG8_BAR;
            PG8_LDA(At, 1, 1); PG8_STAGE(PG8_SA(1, 0), a3, voffA);
            PG8_BAR; PG8_WAIT_L(0); PG8_MMA(1, 0, At, B0); PG8_BAR; PG8_SCHED;
            PG8_STAGE(PG8_SB(1, 1), b3 + hstep, voffB);
            PG8_WAIT_V(6); PG8_BAR; PG8_MMA(1, 1, At, B1); PG8_BAR;
            }
        }
        if constexpr (ALIGN_EPI) { if (wr == 0) PG8_BAR; }
        if constexpr (!Epi::AFTER_DRAIN) { E(acc, cur, wr, wc, fr, fq); S.done(cur); }
        if (!has_next) break;
        if (!(Epi::HAS_MID && cur.seg == 0)) {
#pragma unroll
        for (int a = 0; a < 2; ++a)
#pragma unroll
            for (int b = 0; b < 2; ++b)
#pragma unroll
                for (int m = 0; m < 4; ++m)
#pragma unroll
                    for (int n = 0; n < 2; ++n) acc[a][b][m][n] = (f32x4){0.f, 0.f, 0.f, 0.f};
        }
        cur = nxt; cA = nA; cB = nB; ++ui;
        if constexpr (ALIGN_EPI) { if (wr == 1) PG8_BAR; }
    }
    PG8_WAIT_V(0);
    if constexpr (!ALIGN_EPI) { if (wr == 0) PG8_BAR; }
    PG8_BAR;
    if constexpr (Epi::AFTER_DRAIN) { E.fused(acc, cur, wr, wc, fr, fq, lds, wid, lane); S.done(cur); }
#undef PG8_SA
#undef PG8_SB
#undef PG8_STAGE
#undef PG8_LDA
#undef PG8_LDB
#undef PG8_MMA
#undef PG8_WAIT_V
#undef PG8_WAIT_L
#undef PG8_BAR
#undef PG8_SCHED
}
}

#define LAS __attribute__((address_space(3)))
typedef unsigned short bf16;
typedef pg8::f32x4 f32x4; typedef pg8::bf16x8 bf16x8; typedef pg8::u32x4 u32x4;
typedef unsigned u32x2 __attribute__((ext_vector_type(2)));

#ifndef MK_ONE_LAUNCH
#define MK_ONE_LAUNCH 1
#endif

constexpr int D = 1024, MP = 16384, MS = 128, MV = MP + MS, MT = 16640, TT = 2048, NL = 4;
constexpr int CC = 512, KW = 31, HD = 128, QKVD = 1536, DFF = 2816, INDIM = 5128, NIN = 5120, NF1 = 5632, NMOD = 6144, NMODROW = 136, MODLD = 4 * NMOD;
constexpr int NPH = 43;
constexpr int LDS_BYTES = 147456;
constexpr size_t MiB = 1u << 20;
constexpr size_t WS_SC = 1 * MiB, WS_MOD = 2 * MiB, WS_BG = 15 * MiB, WS_EGL = 16 * MiB, WS_W = 18 * MiB;
constexpr size_t LW_IN = 0, LW_C = 10485760, LW_D = 11534336, LW_M = 12582912, LW_F1 = 14680064, LW_F2 = 26214400, LW_SZ = 31981568;
constexpr size_t WS_X = 140 * MiB, WS_H = 205 * MiB, WS_Y = WS_H;
constexpr size_t WS_U = 238 * MiB, WS_OB = WS_U, WS_QKV = 255 * MiB, WS_MG = WS_QKV, WS_ZS = 304 * MiB, WS_MA = 321 * MiB, WS_MB = 354 * MiB, WS_CA = 387 * MiB;
constexpr size_t WS_DW = 404 * MiB, WS_DQG = 420 * MiB, WS_DKDT = 436 * MiB, WS_DQKD = 452 * MiB, WS_DU = 460 * MiB, WS_O = 492 * MiB, WS_END = 525 * MiB;
constexpr size_t WS_HH = 238 * MiB, WS_WADA = 404 * MiB;
constexpr size_t OUT_Y = 0, OUT_CONF_P = 16908288, OUT_CONF_S = 17399808, OUT_SHORT_P = 25264128, OUT_SHORT_S = 25411584, OUT_DELTA_P = 27770880, OUT_DELTA_S = 29868032;

struct Args { const float* in[26]; float* out; unsigned char* ws; int ph_lo, ph_hi; };

__device__ __forceinline__ float bf2f(bf16 b) { return __uint_as_float(((unsigned)b) << 16); }
__device__ __forceinline__ unsigned f2bf(float f) { unsigned u = __float_as_uint(f); return (u + 0x7fffu + ((u >> 16) & 1u)) >> 16; }
typedef float f32x2_t __attribute__((ext_vector_type(2))); typedef __bf16 bf16x2_t __attribute__((ext_vector_type(2)));
__device__ __forceinline__ unsigned pk2(float lo, float hi) { f32x2_t v = {lo, hi}; bf16x2_t r = __builtin_convertvector(v, bf16x2_t); return __builtin_bit_cast(unsigned, r); }
__device__ __forceinline__ float sigm(float x) { return __builtin_amdgcn_rcpf(1.f + __expf(-x)); }
__device__ __forceinline__ float silu(float x) { return x * __builtin_amdgcn_rcpf(1.f + __expf(-x)); }
template <int CTRL, int RMASK> __device__ __forceinline__ float dpp_get(float v) { return __builtin_bit_cast(float, __builtin_amdgcn_update_dpp(0, __builtin_bit_cast(int, v), CTRL, RMASK, 0xF, false)); }
__device__ __forceinline__ float wave_sum(float v) {
    v += dpp_get<0xB1, 0xF>(v); v += dpp_get<0x4E, 0xF>(v); v += dpp_get<0x141, 0xF>(v); v += dpp_get<0x140, 0xF>(v);
    v += dpp_get<0x142, 0xA>(v); v += dpp_get<0x143, 0xC>(v);
    return __builtin_bit_cast(float, __builtin_amdgcn_readlane(__builtin_bit_cast(int, v), 63));
}
__device__ __forceinline__ float oct_sum(float v) { v += dpp_get<0xB1, 0xF>(v); v += dpp_get<0x4E, 0xF>(v); v += dpp_get<0x141, 0xF>(v); return v; }
__device__ __forceinline__ float row16_sum(float v) { v = oct_sum(v); v += dpp_get<0x140, 0xF>(v); return v; }
__device__ __forceinline__ int ltid() { int t = threadIdx.x; asm volatile("" : "+v"(t)); return t; }
__device__ __forceinline__ int lbid() { int t = blockIdx.x; asm volatile("" : "+s"(t)); return t; }
#define LDS_WAIT() asm volatile("s_waitcnt lgkmcnt(0)" ::: "memory")
#define LBAR() do { asm volatile("s_waitcnt lgkmcnt(0)" ::: "memory"); __builtin_amdgcn_s_barrier(); asm volatile("" ::: "memory"); } while (0)

#define XB_TMO      128
#define XB_XCNT(j)  (256  + 64 * (j))
#define XB_XSUB(j)  (1280 + 64 * (j))
#define XB_XGEN(j)  (2304 + 64 * (j))
#define XB_TOP      3328
#define XB_TOPGEN   3392
#define XCD_BAR_WORDS 3456
#define XB_SPIN_CAP (1u << 18)

__device__ __forceinline__ unsigned xb_ld(unsigned* p)              { return __hip_atomic_load(p, __ATOMIC_RELAXED, __HIP_MEMORY_SCOPE_AGENT); }
__device__ __forceinline__ unsigned xb_add(unsigned* p, unsigned v) { return __hip_atomic_fetch_add(p, v, __ATOMIC_RELAXED, __HIP_MEMORY_SCOPE_AGENT); }
__device__ __forceinline__ unsigned xb_xcc_id() { return (unsigned)__builtin_amdgcn_s_getreg((3 << 11) | 20) & 0xFu; }
#define XB_SPIN(cond, bar) do { unsigned _sp = 0; while (cond) { __builtin_amdgcn_s_sleep(1); \
    if ((++_sp & 255u) == 0u) { if (xb_ld(&(bar)[XB_TMO])) break; if (_sp > XB_SPIN_CAP) { atomicAdd(&(bar)[XB_TMO], 1u); break; } } } } while (0)

struct XcdBarrier {
    unsigned* bar; unsigned x;
    volatile LAS unsigned* st;
};

__device__ __forceinline__ XcdBarrier xcd_barrier_post(unsigned* bar, volatile LAS unsigned* st) {
    XcdBarrier b; b.bar = bar; b.x = xb_xcc_id(); b.st = st;
    if (threadIdx.x == 0) (void)xb_add(&bar[XB_XCNT(b.x)], 1u);
    return b;
}
__device__ __forceinline__ void xcd_barrier_complete(unsigned* bar, unsigned x, unsigned& nloc, unsigned& nx) {
    const unsigned G = gridDim.x * gridDim.y * gridDim.z;
    unsigned sum, cnt, mine, sp = 0u;
    for (;;) {
        sum = 0u; cnt = 0u; mine = 0u;
#pragma unroll
        for (unsigned j = 0; j < 16; ++j) { const unsigned c = xb_ld(&bar[XB_XCNT(j)]); sum += c; cnt += (c > 0u) ? 1u : 0u; mine = (j == x) ? c : mine; }
        if (sum == G) break;
        __builtin_amdgcn_s_sleep(1);
        if ((++sp & 255u) == 0u) { if (xb_ld(&bar[XB_TMO])) break; if (sp > XB_SPIN_CAP) { atomicAdd(&bar[XB_TMO], 1u); break; } }
    }
    nloc = mine > 0u ? mine : 1u; nx = cnt > 0u ? cnt : 1u;
}

__device__ __forceinline__ void xcd_barrier(const XcdBarrier& b) {
    asm volatile("s_waitcnt vmcnt(0)" ::: "memory");
    __syncthreads();
    if (threadIdx.x == 0) {
        unsigned* bar = b.bar;
        __builtin_amdgcn_s_waitcnt(0);
        unsigned nloc = b.st[0], nx = b.st[1];
        if (nloc == 0u) { xcd_barrier_complete(bar, b.x, nloc, nx); b.st[0] = nloc; b.st[1] = nx; }
        const unsigned old = xb_add(&bar[XB_XSUB(b.x)], 1u);
        const unsigned gen = old / nloc;
        if (old + 1u == (gen + 1u) * nloc) {
            __builtin_amdgcn_fence(__ATOMIC_RELEASE, "agent");
            asm volatile("s_waitcnt vmcnt(0)" ::: "memory");
            const unsigned og = xb_add(&bar[XB_TOP], 1u);
            const unsigned tg = og / nx;
            if (og + 1u == (tg + 1u) * nx) xb_add(&bar[XB_TOPGEN], 1u);
            else XB_SPIN(xb_ld(&bar[XB_TOPGEN]) == tg, bar);
            __builtin_amdgcn_fence(__ATOMIC_ACQUIRE, "agent");
            xb_add(&bar[XB_XGEN(b.x)], 1u);
            asm volatile("s_waitcnt vmcnt(0)" ::: "memory");
        } else {
            XB_SPIN(xb_ld(&bar[XB_XGEN(b.x)]) == gen, bar);
            __builtin_amdgcn_fence(__ATOMIC_ACQUIRE, "agent");
            asm volatile("s_waitcnt vmcnt(0)" ::: "memory");
        }
    }
    __syncthreads();
}

__device__ __forceinline__ int src_col_in(int n) { const int pn = n >> 8, r = n & 255; if (pn < 4) return ((r >> 7) ? 512 : 0) + 128 * pn + (r & 127); if (pn < 12) return n; return n + 8; }
__device__ __forceinline__ int src_col_f1(int n) { const int pn = n >> 8, r = n & 255; return ((r >> 7) ? DFF : 0) + 128 * pn + (r & 127); }

__device__ __forceinline__ void tr_item(const float* W, int Nsrc, int nsrc0, int K, bf16* WTrow0, int k0, LAS float* scr, int lane) {
    f32x4 v[8];
#pragma unroll
    for (int i = 0; i < 8; ++i) v[i] = __builtin_nontemporal_load((const f32x4*)(W + (size_t)(k0 + (lane >> 3) + 8 * i) * Nsrc + nsrc0 + 4 * (lane & 7)));
#pragma unroll
    for (int i = 0; i < 8; ++i) { LAS float* p = scr + ((lane >> 3) + 8 * i) * 33 + 4 * (lane & 7); p[0] = v[i][0]; p[1] = v[i][1]; p[2] = v[i][2]; p[3] = v[i][3]; }
    LDS_WAIT();
    const int c = lane & 7;
#pragma unroll
    for (int j = 0; j < 4; ++j) { const int n = (lane >> 3) + 8 * j; const LAS float* s = scr + (8 * c) * 33 + n;
        u32x4 o; o.x = pk2(s[0 * 33], s[1 * 33]); o.y = pk2(s[2 * 33], s[3 * 33]); o.z = pk2(s[4 * 33], s[5 * 33]); o.w = pk2(s[6 * 33], s[7 * 33]);
        *(u32x4*)(WTrow0 + (size_t)n * K + k0 + 8 * c) = o; }
    LDS_WAIT();
}
__device__ __forceinline__ void tr_mat(const float* W, int Nsrc, int K, int Ndst, int map, bf16* WT, int r, LAS float* scr, int lane) {
    const int nblk = Ndst / 32, kb = r / nblk, nb = r % nblk, n0 = 32 * nb;
    const int ns = map == 0 ? n0 : (map == 1 ? src_col_in(n0) : src_col_f1(n0));
    tr_item(W, Nsrc, ns, K, WT + (size_t)n0 * K, 64 * kb, scr, lane);
}
__device__ __forceinline__ void convert_layer(const Args& a, LAS unsigned char* lds, int l, int gw, int NGW) {
    const int tid = ltid(), lane = tid & 63, wave = tid >> 6;
    LAS float* scr = (LAS float*)(lds + wave * 16384);
    constexpr int I_IN = 16 * 160, I_C = 8 * 32, I_M = 16 * 32, I_F1 = 16 * 176, I_F2 = 44 * 32, I_LAYER = I_IN + 2 * I_C + I_M + I_F1 + I_F2;
    unsigned char* lw = a.ws + WS_W + (size_t)l * LW_SZ;
    for (int it = gw; it < I_LAYER; it += NGW) {
        int r = it;
        if (r < I_IN) { tr_mat(a.in[10] + (size_t)l * 1024 * INDIM, INDIM, 1024, NIN, 1, (bf16*)(lw + LW_IN), r, scr, lane); continue; } r -= I_IN;
        if (r < I_C) { tr_mat(a.in[15] + (size_t)l * 512 * 1024, 1024, 512, 1024, 0, (bf16*)(lw + LW_C), r, scr, lane); continue; } r -= I_C;
        if (r < I_C) { tr_mat(a.in[20] + (size_t)l * 512 * 1024, 1024, 512, 1024, 0, (bf16*)(lw + LW_D), r, scr, lane); continue; } r -= I_C;
        if (r < I_M) { tr_mat(a.in[21] + (size_t)l * 1024 * 1024, 1024, 1024, 1024, 0, (bf16*)(lw + LW_M), r, scr, lane); continue; } r -= I_M;
        if (r < I_F1) { tr_mat(a.in[23] + (size_t)l * 1024 * NF1, NF1, 1024, NF1, 2, (bf16*)(lw + LW_F1), r, scr, lane); continue; } r -= I_F1;
        tr_mat(a.in[24] + (size_t)l * DFF * 1024, 1024, DFF, 1024, 0, (bf16*)(lw + LW_F2), r, scr, lane);
    }
}
__device__ __forceinline__ void phase_p0a(const Args& a, LAS unsigned char* lds) {
    const int tid = ltid(), lane = tid & 63, wave = tid >> 6, bid = lbid();
    LAS float* scr = (LAS float*)(lds + wave * 16384);
    const int gw = bid * 8 + wave, NGW = gridDim.x * 8;
    constexpr int I_ADA = 16 * 192;
    for (int it = gw; it < 4 * I_ADA; it += NGW) { const int l = it / I_ADA, r = it - l * I_ADA;
        tr_mat(a.in[7] + (size_t)l * 1024 * NMOD, NMOD, 1024, NMOD, 0, (bf16*)(a.ws + WS_WADA) + (size_t)l * NMOD * 1024, r, scr, lane); }
    bf16* SC = (bf16*)(a.ws + WS_SC);
    for (int i = bid * 512 + tid; i < 256 * 1024 / 2; i += gridDim.x * 512) {
        const int row = (2 * i) >> 10, k = (2 * i) & 1023;
        float v0 = 0.f, v1 = 0.f;
        if (row < 8) { v0 = a.in[2][row * 1024 + k]; v1 = a.in[2][row * 1024 + k + 1]; }
        else if (row < NMODROW) { v0 = a.in[3][(row - 8) * 1024 + k]; v1 = a.in[3][(row - 8) * 1024 + k + 1]; }
        ((unsigned*)SC)[i] = pk2(silu(v0), silu(v1));
    }
}

template <int ACT>
__device__ __forceinline__ void epi_store_bf16(const f32x4 (&acc)[2][2][4][2], bf16* base, int ldc, int row0, int col0) {
#pragma unroll
    for (int ai = 0; ai < 2; ++ai)
#pragma unroll
        for (int m = 0; m < 4; ++m) { bf16* rowp = base + (size_t)(row0 + ai * 128 + m * 16) * ldc + col0;
#pragma unroll
            for (int bj = 0; bj < 2; ++bj) { f32x4 v0 = acc[ai][bj][m][0], v1 = acc[ai][bj][m][1];
                if (ACT == 1) {
#pragma unroll
                    for (int j = 0; j < 4; ++j) { v0[j] = silu(v0[j]); v1[j] = silu(v1[j]); } }
                if (ACT == 2) {
#pragma unroll
                    for (int j = 0; j < 4; ++j) { v0[j] = sigm(v0[j]); v1[j] = sigm(v1[j]); } }
                u32x4 w; w.x = pk2(v0[0], v0[1]); w.y = pk2(v0[2], v0[3]); w.z = pk2(v1[0], v1[1]); w.w = pk2(v1[2], v1[3]);
                *(u32x4*)(rowp + bj * 128) = w; __builtin_amdgcn_sched_barrier(0); } }
}
template <int MODE>
__device__ __forceinline__ void epi_store_glu(const f32x4 (&acc)[2][2][4][2], bf16* base, int ldc, int row0, int col0) {
#pragma unroll
    for (int ai = 0; ai < 2; ++ai)
#pragma unroll
        for (int m = 0; m < 4; ++m) { bf16* rowp = base + (size_t)(row0 + ai * 128 + m * 16) * ldc + col0;
            f32x4 v[2];
#pragma unroll
            for (int n = 0; n < 2; ++n)
#pragma unroll
                for (int j = 0; j < 4; ++j) { const float x = acc[ai][0][m][n][j], y = acc[ai][1][m][n][j]; v[n][j] = MODE == 0 ? x * sigm(y) : silu(x) * y; }
            u32x4 w; w.x = pk2(v[0][0], v[0][1]); w.y = pk2(v[0][2], v[0][3]); w.z = pk2(v[1][0], v[1][1]); w.w = pk2(v[1][2], v[1][3]);
            *(u32x4*)rowp = w; __builtin_amdgcn_sched_barrier(0); }
}
struct EpiIn { static constexpr bool PERM = true, AFTER_DRAIN = false, HAS_MID = false; bf16 *U, *QKV, *ZS, *MA, *MB;
    __device__ __forceinline__ void operator()(const f32x4 (&acc)[2][2][4][2], const pg8::Unit& u, int wr, int wc, int fr, int fq) const {
        const int row0 = u.pm * 256 + wr * 64 + fr, cw = wc * 32 + 8 * fq, pn = u.pn;
        if (pn < 4) epi_store_glu<0>(acc, U, CC, row0, 128 * pn + cw);
        else if (pn < 10) epi_store_bf16<0>(acc, QKV, QKVD, row0, 256 * (pn - 4) + cw);
        else if (pn < 12) epi_store_bf16<1>(acc, ZS, CC, row0, 256 * (pn - 10) + cw);
        else if (pn < 16) epi_store_bf16<2>(acc, MA, D, row0, 256 * (pn - 12) + cw);
        else epi_store_bf16<2>(acc, MB, D, row0, 256 * (pn - 16) + cw);
    }
};
struct EpiSwi { static constexpr bool PERM = true, AFTER_DRAIN = false, HAS_MID = false; bf16* HH;
    __device__ __forceinline__ void operator()(const f32x4 (&acc)[2][2][4][2], const pg8::Unit& u, int wr, int wc, int fr, int fq) const {
        epi_store_glu<1>(acc, HH, DFF, u.pm * 256 + wr * 64 + fr, 128 * u.pn + wc * 32 + 8 * fq);
    }
};
template <bool ADD> struct EpiGate { static constexpr bool PERM = true, AFTER_DRAIN = false, HAS_MID = false; const bf16* G; const bf16* Yin; bf16* Out;
    __device__ __forceinline__ void operator()(const f32x4 (&acc)[2][2][4][2], const pg8::Unit& u, int wr, int wc, int fr, int fq) const {
        const int row0 = u.pm * 256 + wr * 64 + fr, col0 = u.pn * 256 + wc * 32 + 8 * fq;
#pragma unroll
        for (int ai = 0; ai < 2; ++ai)
#pragma unroll
            for (int m = 0; m < 4; ++m) { const size_t off = (size_t)(row0 + ai * 128 + m * 16) * D + col0;
#pragma unroll
                for (int bj = 0; bj < 2; ++bj) {
                    const u32x4 g = *(const u32x4*)(G + off + bj * 128); u32x4 y = (u32x4){0u, 0u, 0u, 0u}; if (ADD) y = *(const u32x4*)(Yin + off + bj * 128);
                    float o[8];
#pragma unroll
                    for (int j = 0; j < 8; ++j) { const unsigned gw = g[j >> 1], yw = y[j >> 1];
                        const float gf = (j & 1) ? __uint_as_float(gw & 0xffff0000u) : __uint_as_float(gw << 16);
                        const float yf = (j & 1) ? __uint_as_float(yw & 0xffff0000u) : __uint_as_float(yw << 16);
                        o[j] = (ADD ? yf : 0.f) + gf * acc[ai][bj][m][j >> 2][j & 3]; }
                    u32x4 w; w.x = pk2(o[0], o[1]); w.y = pk2(o[2], o[3]); w.z = pk2(o[4], o[5]); w.w = pk2(o[6], o[7]);
                    *(u32x4*)(Out + off + bj * 128) = w; } }
    }
};
struct EpiMerge { static constexpr bool PERM = true, AFTER_DRAIN = false, HAS_MID = true; const bf16* SA; const bf16* SB; bf16* Out;
    __device__ __forceinline__ void operator()(f32x4 (&acc)[2][2][4][2], const pg8::Unit& u, int wr, int wc, int fr, int fq) const {
        const int row0 = u.pm * 256 + wr * 64 + fr, col0 = u.pn * 256 + wc * 32 + 8 * fq;
#pragma unroll
        for (int ai = 0; ai < 2; ++ai)
#pragma unroll
            for (int m = 0; m < 4; ++m) { const size_t off = (size_t)(row0 + ai * 128 + m * 16) * D + col0;
#pragma unroll
                for (int bj = 0; bj < 2; ++bj) {
                    if (u.seg == 0) { const u32x4 sa = *(const u32x4*)(SA + off + bj * 128), sb = *(const u32x4*)(SB + off + bj * 128);
#pragma unroll
                        for (int j = 0; j < 8; ++j) { const unsigned aw = sa[j >> 1], bw = sb[j >> 1];
                            const float af = (j & 1) ? __uint_as_float(aw & 0xffff0000u) : __uint_as_float(aw << 16);
                            const float bf = (j & 1) ? __uint_as_float(bw & 0xffff0000u) : __uint_as_float(bw << 16);
                            acc[ai][bj][m][j >> 2][j & 3] *= bf * __builtin_amdgcn_rcpf(fmaxf(af, 1e-30f)); } }
                    else { const u32x4 sa = *(const u32x4*)(SA + off + bj * 128);
                        float o[8];
#pragma unroll
                        for (int j = 0; j < 8; ++j) { const unsigned aw = sa[j >> 1]; const float af = (j & 1) ? __uint_as_float(aw & 0xffff0000u) : __uint_as_float(aw << 16);
                            o[j] = af * acc[ai][bj][m][j >> 2][j & 3]; }
                        u32x4 w; w.x = pk2(o[0], o[1]); w.y = pk2(o[2], o[3]); w.z = pk2(o[4], o[5]); w.w = pk2(o[6], o[7]);
                        *(u32x4*)(Out + off + bj * 128) = w; } } }
    }
};
struct EpiRes { static constexpr bool PERM = false, AFTER_DRAIN = false, HAS_MID = false; const float* xp; const float* xs; const float* Xin; float* Xout; const float* gt; int use_in;
    __device__ __forceinline__ void operator()(const f32x4 (&acc)[2][2][4][2], const pg8::Unit& u, int wr, int wc, int fr, int fq) const {
        const int row0 = u.pm * 256 + wr * 64 + fr, col0 = u.pn * 256 + wc * 32 + 4 * fq;
#pragma unroll
        for (int ai = 0; ai < 2; ++ai)
#pragma unroll
            for (int m = 0; m < 4; ++m) { const int row = row0 + ai * 128 + m * 16;
                if (row < MV) {
                    const float* xi = use_in ? (row < MP ? xp + (size_t)row * D : xs + (size_t)(row - MP) * D) : Xin + (size_t)row * D;
                    const int mr = row < MP ? (row >> 11) : 8 + (row - MP);
                    const float* g = gt + (size_t)mr * MODLD; float* xo = Xout + (size_t)row * D;
#pragma unroll
                    for (int bj = 0; bj < 2; ++bj)
#pragma unroll
                        for (int n = 0; n < 2; ++n) { const int c = col0 + bj * 128 + n * 16;
                            *(f32x4*)(xo + c) = *(const f32x4*)(xi + c) + *(const f32x4*)(g + c) * acc[ai][bj][m][n]; } } }
    }
};
struct EpiMod { static constexpr bool PERM = false, AFTER_DRAIN = false, HAS_MID = false; float* MOD; const float* bias;
    __device__ __forceinline__ void operator()(const f32x4 (&acc)[2][2][4][2], const pg8::Unit& u, int wr, int wc, int fr, int fq) const {
        const int row0 = u.pm * 256 + wr * 64 + fr, col0 = u.pn * 256 + wc * 32 + 4 * fq;
#pragma unroll
        for (int ai = 0; ai < 2; ++ai)
#pragma unroll
            for (int m = 0; m < 4; ++m) { const int row = row0 + ai * 128 + m * 16;
                if (row < NMODROW) {
#pragma unroll
                    for (int bj = 0; bj < 2; ++bj)
#pragma unroll
                        for (int n = 0; n < 2; ++n) { const int c = col0 + bj * 128 + n * 16;
                            *(f32x4*)(MOD + (size_t)row * MODLD + c) = *(const f32x4*)(bias + c) + acc[ai][bj][m][n]; } } }
    }
};

template <int RT, int CT, int BS = 4, class EpiS>
__device__ __forceinline__ void splitk_units(LAS unsigned char* lds, const bf16* As, const bf16* Bt, int K, int NCG, const EpiS& E, int bid = -1, int G = 0) {
    const int tid = ltid(), lane = tid & 63, w = tid >> 6, fr = lane & 15, fq = lane >> 4;
    if (bid < 0) { bid = lbid(); G = (int)gridDim.x; }
    const int n_units = (8 / RT) * NCG, kw = K >> 3, nks = kw >> 5;
    LAS f32x4* part = (LAS f32x4*)lds;
    for (int u = bid; u < n_units; u += G) {
        const int rg = u / NCG, cg = u % NCG;
        const bf16* ap[RT]; const bf16* bp[CT];
#pragma unroll
        for (int r = 0; r < RT; ++r) ap[r] = As + (size_t)(16 * (rg * RT + r) + fr) * K + w * kw + 8 * fq;
#pragma unroll
        for (int c = 0; c < CT; ++c) bp[c] = Bt + (size_t)(E.brow(cg, c) + fr) * K + w * kw + 8 * fq;
        f32x4 acc[RT][CT];
#pragma unroll
        for (int r = 0; r < RT; ++r)
#pragma unroll
            for (int c = 0; c < CT; ++c) acc[r][c] = (f32x4){0.f, 0.f, 0.f, 0.f};
#pragma unroll 1
        for (int s0 = 0; s0 < nks; s0 += BS) {
            bf16x8 av[BS][RT], bv[BS][CT];
#pragma unroll
            for (int s = 0; s < BS; ++s) { const int so = (s0 + s < nks) ? 32 * (s0 + s) : 32 * s0;
#pragma unroll
                for (int r = 0; r < RT; ++r) av[s][r] = *(const bf16x8*)(ap[r] + so);
#pragma unroll
                for (int c = 0; c < CT; ++c) bv[s][c] = *(const bf16x8*)(bp[c] + so); }
#pragma unroll
            for (int s = 0; s < BS; ++s) if (s0 + s < nks) {
#pragma unroll
                for (int r = 0; r < RT; ++r)
#pragma unroll
                    for (int c = 0; c < CT; ++c) acc[r][c] = __builtin_amdgcn_mfma_f32_16x16x32_bf16(av[s][r], bv[s][c], acc[r][c], 0, 0, 0); }
        }
#pragma unroll
        for (int r = 0; r < RT; ++r)
#pragma unroll
            for (int c = 0; c < CT; ++c) part[((w * RT + r) * CT + c) * 64 + lane] = acc[r][c];
        LBAR();
        if (w < RT) { f32x4 sum[CT];
#pragma unroll
            for (int c = 0; c < CT; ++c) { f32x4 s = part[((0 * RT + w) * CT + c) * 64 + lane];
#pragma unroll
                for (int ww = 1; ww < 8; ++ww) s += part[((ww * RT + w) * CT + c) * 64 + lane];
                sum[c] = s; }
            E(cg, 16 * (rg * RT + w) + 4 * fq, fr, sum); }
        LBAR();
    }
}
struct SkGlu { static constexpr int CT = 2; bf16* U;
    __device__ __forceinline__ int brow(int cg, int c) const { const int oc = 16 * cg; return 256 * (oc >> 7) + (oc & 127) + 128 * c; }
    __device__ __forceinline__ void operator()(int cg, int s0, int fr, const f32x4 (&a)[2]) const {
#pragma unroll
        for (int e = 0; e < 4; ++e) U[(size_t)(MP + s0 + e) * CC + 16 * cg + fr] = (bf16)f2bf(a[0][e] * sigm(a[1][e])); }
};
struct SkIn { static constexpr int CT = 4; bf16 *QKV, *ZS, *MA, *MB;
    __device__ __forceinline__ int brow(int cg, int c) const { return 1024 + 64 * cg + 16 * c; }
    __device__ __forceinline__ void operator()(int cg, int s0, int fr, const f32x4 (&a)[4]) const {
#pragma unroll
        for (int c = 0; c < 4; ++c) { const int n = 1024 + 64 * cg + 16 * c + fr;
#pragma unroll
            for (int e = 0; e < 4; ++e) { const size_t r = (size_t)(MP + s0 + e); const float v = a[c][e];
                if (n < 2560) QKV[r * QKVD + n - 1024] = (bf16)f2bf(v);
                else if (n < 3072) ZS[r * CC + n - 2560] = (bf16)f2bf(silu(v));
                else if (n < 4096) MA[r * D + n - 3072] = (bf16)f2bf(sigm(v));
                else MB[r * D + n - 4096] = (bf16)f2bf(sigm(v)); } } }
};
struct SkInAll { static constexpr int CT = 5; bf16 *U, *QKV, *ZS, *MA, *MB;
    __device__ __forceinline__ int plain_tile(int cg, int c) const { return cg < 32 ? 3 * cg + (c - 2) : 96 + 5 * (cg - 32) + c; }
    __device__ __forceinline__ int brow(int cg, int c) const { if (cg < 32 && c < 2) { const int oc = 16 * cg; return 256 * (oc >> 7) + (oc & 127) + 128 * c; } return 1024 + 16 * plain_tile(cg, c); }
    __device__ __forceinline__ void operator()(int cg, int s0, int fr, const f32x4 (&a)[5]) const {
        if (cg < 32) {
#pragma unroll
            for (int e = 0; e < 4; ++e) U[(size_t)(MP + s0 + e) * CC + 16 * cg + fr] = (bf16)f2bf(a[0][e] * sigm(a[1][e])); }
#pragma unroll
        for (int c = 0; c < 5; ++c) { if (cg < 32 && c < 2) continue;
            const int n = 1024 + 16 * plain_tile(cg, c) + fr;
#pragma unroll
            for (int e = 0; e < 4; ++e) { const size_t r = (size_t)(MP + s0 + e); const float v = a[c][e];
                if (n < 2560) QKV[r * QKVD + n - 1024] = (bf16)f2bf(v);
                else if (n < 3072) ZS[r * CC + n - 2560] = (bf16)f2bf(silu(v));
                else if (n < 4096) MA[r * D + n - 3072] = (bf16)f2bf(sigm(v));
                else MB[r * D + n - 4096] = (bf16)f2bf(sigm(v)); } }
    }
};
template <bool ADD> struct SkGate { static constexpr int CT = 2; const bf16* G; const bf16* Yin; bf16* Out;
    __device__ __forceinline__ int brow(int cg, int c) const { return 32 * cg + 16 * c; }
    __device__ __forceinline__ void operator()(int cg, int s0, int fr, const f32x4 (&a)[2]) const {
#pragma unroll
        for (int c = 0; c < 2; ++c)
#pragma unroll
            for (int e = 0; e < 4; ++e) { const size_t o = (size_t)(MP + s0 + e) * D + 32 * cg + 16 * c + fr;
                Out[o] = (bf16)f2bf((ADD ? bf2f(Yin[o]) : 0.f) + bf2f(G[o]) * a[c][e]); } }
};
struct SkRes { static constexpr int CT = 2; const float* xs; const float* Xin; float* Xout; const float* gt; int use_in;
    __device__ __forceinline__ int brow(int cg, int c) const { return 32 * cg + 16 * c; }
    __device__ __forceinline__ void operator()(int cg, int s0, int fr, const f32x4 (&a)[2]) const {
#pragma unroll
        for (int e = 0; e < 4; ++e) { const int s = s0 + e; const float* xi = use_in ? xs + (size_t)s * D : Xin + (size_t)(MP + s) * D;
#pragma unroll
            for (int c = 0; c < 2; ++c) { const int col = 32 * cg + 16 * c + fr;
                Xout[(size_t)(MP + s) * D + col] = xi[col] + gt[(size_t)(8 + s) * MODLD + col] * a[c][e]; } } }
};
template <class Epi> __device__ __forceinline__ void run_gemm_sub(LAS unsigned char* lds, const bf16* A, const bf16* Bt, int M, int N, int K, const Epi& E, int c, int G) {
    pg8::Gemm g{A, Bt, M, N, K}; pg8::StaticOrder S; S.init(M, N, G, c);
    pg8::gemm_phase<Epi, pg8::StaticOrder, true, true>(lds, g, S, E);
}
template <class Epi> __device__ __forceinline__ void run_gemm(LAS unsigned char* lds, const bf16* A, const bf16* Bt, int M, int N, int K, const Epi& E) {
    pg8::Gemm g{A, Bt, M, N, K}; pg8::StaticOrder S; S.init(M, N, (int)gridDim.x, lbid());
    pg8::gemm_phase<Epi, pg8::StaticOrder, true, true>(lds, g, S, E);
}

__device__ __forceinline__ const float* xrow_ptr(const Args& a, int use_in, int m) {
    return use_in ? (m < MP ? a.in[0] + (size_t)m * D : a.in[1] + (size_t)(m - MP) * D) : (const float*)(a.ws + WS_X) + (size_t)m * D;
}
template <int WHICH>
__device__ __forceinline__ void norm_row(const Args& a, int l, int m, f32x4 (&v)[4], const f32x4 (&gs)[4], const f32x4 (&shv)[4], LAS float* wba, int lane) {
    float ss = 0.f;
#pragma unroll
    for (int j = 0; j < 4; ++j) ss += (v[j][0] * v[j][0] + v[j][1] * v[j][1]) + (v[j][2] * v[j][2] + v[j][3] * v[j][3]);
    const float rstd = rsqrtf(wave_sum(ss) * (1.f / D) + 1e-6f);
    u32x2* hp = (u32x2*)((bf16*)(a.ws + WS_H) + (size_t)m * D) + lane;
#pragma unroll
    for (int j = 0; j < 4; ++j) { v[j] = v[j] * rstd * gs[j] + shv[j];
        u32x2 o; o.x = pk2(v[j][0], v[j][1]); o.y = pk2(v[j][2], v[j][3]); hp[64 * j] = o; }
    if (WHICH == 0) {
        float p[8];
#pragma unroll
        for (int c = 0; c < 8; ++c) { float s = 0.f;
#pragma unroll
            for (int j = 0; j < 4; ++j) { const f32x4 w = *(const LAS f32x4*)(wba + c * 1024 + 4 * (lane + 64 * j)); s += (v[j][0] * w[0] + v[j][1] * w[1]) + (v[j][2] * w[2] + v[j][3] * w[3]); }
            p[c] = wave_sum(s); if (c & 1) __builtin_amdgcn_sched_barrier(0); }
        float val = p[0];
#pragma unroll
        for (int c = 1; c < 8; ++c) val = (lane == c) ? p[c] : val;
        if (lane < 8) { const int hh = lane & 3; float o;
            if (lane < 4) o = sigm(val);
            else { const float x = val + a.in[18][l * 4 + hh]; const float sp = x > 20.f ? x : log1pf(__expf(x)); o = -__expf(a.in[17][l * 4 + hh]) * sp; }
            ((float*)(a.ws + WS_BG))[(size_t)m * 8 + lane] = o; }
    }
}
template <int WHICH>
__device__ __forceinline__ void load_mod(const Args& a, int l, int mr, int lane, f32x4 (&gs)[4], f32x4 (&shv)[4]) {
    const float* mrow = (const float*)(a.ws + WS_MOD) + (size_t)l * NMOD + (size_t)mr * MODLD;
    const f32x4* scp = (const f32x4*)(mrow + (WHICH == 0 ? 1 : 4) * D) + lane; const f32x4* shp = (const f32x4*)(mrow + (WHICH == 0 ? 0 : 3) * D) + lane;
    const f32x4* gp = (const f32x4*)((WHICH == 0 ? a.in[9] : a.in[22]) + (size_t)l * D) + lane;
#pragma unroll
    for (int j = 0; j < 4; ++j) { gs[j] = gp[64 * j] * (scp[64 * j] + 1.f); shv[j] = shp[64 * j]; }
}
template <int WHICH>
__device__ __forceinline__ void phase_norm(const Args& a, LAS unsigned char* lds, int l) {
    const int tid = ltid(), lane = tid & 63, wave = tid >> 6;
    LAS float* wba = (LAS float*)lds;
    if (WHICH == 0) {
        const float* win = a.in[10] + (size_t)l * 1024 * INDIM;
        for (int idx = tid; idx < 8192; idx += 512) { const int k = idx >> 3, c = idx & 7; wba[c * 1024 + k] = win[(size_t)k * INDIM + 3072 + c]; }
        LBAR();
    }
    const int use_in = (WHICH == 0 && l == 0);
    const int gw = lbid() * 8 + wave, NGW = gridDim.x * 8;
    for (int g = gw; g < MP / 8; g += NGW) { const int m0 = 8 * g;
        f32x4 vn[4], vn2[4], gs[4], shv[4];
        { const f32x4* xr = (const f32x4*)xrow_ptr(a, use_in, m0) + lane; const f32x4* xr2 = (const f32x4*)xrow_ptr(a, use_in, m0 + 1) + lane;
#pragma unroll
            for (int j = 0; j < 4; ++j) { vn[j] = xr[64 * j]; vn2[j] = xr2[64 * j]; } }
        load_mod<WHICH>(a, l, m0 >> 11, lane, gs, shv);
#pragma unroll 1
        for (int i = 0; i < 8; ++i) { f32x4 v[4];
#pragma unroll
            for (int j = 0; j < 4; ++j) { v[j] = vn[j]; vn[j] = vn2[j]; }
            if (i + 2 < 8) { const f32x4* xr = (const f32x4*)xrow_ptr(a, use_in, m0 + i + 2) + lane;
#pragma unroll
                for (int j = 0; j < 4; ++j) vn2[j] = xr[64 * j]; }
            norm_row<WHICH>(a, l, m0 + i, v, gs, shv, wba, lane); }
    }
    for (int s = gw; s < MS; s += NGW) { f32x4 v[4], gs[4], shv[4];
        const f32x4* xr = (const f32x4*)xrow_ptr(a, use_in, MP + s) + lane;
#pragma unroll
        for (int j = 0; j < 4; ++j) v[j] = xr[64 * j];
        load_mod<WHICH>(a, l, 8 + s, lane, gs, shv);
        norm_row<WHICH>(a, l, MP + s, v, gs, shv, wba, lane); }
    if (WHICH == 0) LBAR();
}
__device__ __forceinline__ void phase_final(const Args& a) {
    const int tid = ltid(), lane = tid & 63, wave = tid >> 6;
    const int gw = lbid() * 8 + wave, NGW = gridDim.x * 8;
    const f32x4* gp = (const f32x4*)a.in[25] + lane;
    f32x4 vn[4], vn2[4];
    if (gw < MV) { const f32x4* xr = (const f32x4*)((const float*)(a.ws + WS_X) + (size_t)gw * D) + lane;
#pragma unroll
        for (int j = 0; j < 4; ++j) vn[j] = xr[64 * j]; }
    if (gw + NGW < MV) { const f32x4* xr = (const f32x4*)((const float*)(a.ws + WS_X) + (size_t)(gw + NGW) * D) + lane;
#pragma unroll
        for (int j = 0; j < 4; ++j) vn2[j] = xr[64 * j]; }
    for (int m = gw; m < MV; m += NGW) {
        f32x4 v[4]; float ss = 0.f;
#pragma unroll
        for (int j = 0; j < 4; ++j) { v[j] = vn[j]; vn[j] = vn2[j]; ss += (v[j][0] * v[j][0] + v[j][1] * v[j][1]) + (v[j][2] * v[j][2] + v[j][3] * v[j][3]); }
        if (m + 2 * NGW < MV) { const f32x4* xr = (const f32x4*)((const float*)(a.ws + WS_X) + (size_t)(m + 2 * NGW) * D) + lane;
#pragma unroll
            for (int j = 0; j < 4; ++j) vn2[j] = xr[64 * j]; }
        const float rstd = rsqrtf(wave_sum(ss) * (1.f / D) + 1e-6f);
        f32x4* op = (f32x4*)(a.out + OUT_Y + (size_t)m * D) + lane;
#pragma unroll
        for (int j = 0; j < 4; ++j) __builtin_nontemporal_store(v[j] * rstd * gp[64 * j], op + 64 * j);
    }
}

__device__ __forceinline__ void conv_prompt_item(const Args& a, LAS unsigned char* lds, int l, int b, int tb) {
    const int tid = ltid(), lane = tid & 63, wave = tid >> 6;
    LAS bf16* UT = (LAS bf16*)lds;
    LAS float* YT = (LAS float*)(lds + 98304);
    const bf16* U = (const bf16*)(a.ws + WS_U); bf16* CA = (bf16*)(a.ws + WS_CA);
    const int m0 = b * TT + 64 * tb;
    for (int idx = tid; idx < 94 * 64; idx += 512) { const int r = idx >> 6, c16 = idx & 63, t = 64 * tb - 30 + r;
        u32x4 v = (u32x4){0u, 0u, 0u, 0u}; if (t >= 0) v = *(const u32x4*)(U + (size_t)(b * TT + t) * CC + c16 * 8);
        *(LAS u32x4*)(UT + r * CC + c16 * 8) = v; }
    const int c = tid;
    float w[KW];
#pragma unroll
    for (int j = 0; j < KW; ++j) w[j] = a.in[11][(size_t)(l * KW + j) * CC + c];
    const float bias = a.in[12][l * CC + c];
    f32x4 lg[2], lb[2];
#pragma unroll
    for (int q = 0; q < 2; ++q) { lg[q] = *(const f32x4*)(a.in[13] + l * CC + 8 * lane + 4 * q); lb[q] = *(const f32x4*)(a.in[14] + l * CC + 8 * lane + 4 * q); }
    LBAR();
#pragma unroll 1
    for (int qt = 0; qt < 4; ++qt) {
#pragma unroll 1
        for (int g2 = 0; g2 < 2; ++g2) { const int g = 2 * qt + g2;
            float y[8];
#pragma unroll
            for (int t = 0; t < 8; ++t) y[t] = bias;
            const LAS bf16* up = UT + (8 * g) * CC + c;
#pragma unroll
            for (int ib = 0; ib < 38; ib += 8) {
                float xv[8];
#pragma unroll
                for (int i2 = 0; i2 < 8; ++i2) xv[i2] = (ib + i2 < 38) ? bf2f(up[(ib + i2) * CC]) : 0.f;
#pragma unroll
                for (int i2 = 0; i2 < 8; ++i2) { const int i = ib + i2;
#pragma unroll
                    for (int t = 0; t < 8; ++t) { const int j = i - t; if (i < 38 && j >= 0 && j < KW) y[t] += w[j] * xv[i2]; } }
            }
#pragma unroll
            for (int t = 0; t < 8; ++t) YT[(8 * g2 + t) * CC + c] = y[t];
        }
        LBAR();
#pragma unroll
        for (int tt = 0; tt < 2; ++tt) { const int tl = 2 * wave + tt;
            const f32x4 v0 = *(const LAS f32x4*)(YT + tl * CC + 8 * lane), v1 = *(const LAS f32x4*)(YT + tl * CC + 8 * lane + 4);
            const float s = wave_sum((v0[0] + v0[1]) + (v0[2] + v0[3]) + (v1[0] + v1[1]) + (v1[2] + v1[3]));
            const float mu = s * (1.f / CC);
            const f32x4 d0 = v0 - mu, d1 = v1 - mu;
            const float q = wave_sum((d0[0] * d0[0] + d0[1] * d0[1]) + (d0[2] * d0[2] + d0[3] * d0[3]) + (d1[0] * d1[0] + d1[1] * d1[1]) + (d1[2] * d1[2] + d1[3] * d1[3]));
            const float rstd = rsqrtf(q * (1.f / CC) + 1e-5f);
            float o[8];
#pragma unroll
            for (int e = 0; e < 4; ++e) { o[e] = silu(d0[e] * rstd * lg[0][e] + lb[0][e]); o[4 + e] = silu(d1[e] * rstd * lg[1][e] + lb[1][e]); }
            u32x4 pw; pw.x = pk2(o[0], o[1]); pw.y = pk2(o[2], o[3]); pw.z = pk2(o[4], o[5]); pw.w = pk2(o[6], o[7]);
            *(u32x4*)(CA + (size_t)(m0 + 16 * qt + tl) * CC + 8 * lane) = pw; }
        LBAR();
    }
    if (tb == 31) { float* o = a.out + OUT_CONF_P + (size_t)((l * 8 + b) * 30) * CC + c;
#pragma unroll 6
        for (int i = 0; i < 30; ++i) o[(size_t)i * CC] = bf2f(UT[(64 + i) * CC + c]); }
    LBAR();
}
__device__ __forceinline__ void conv_sample_item(const Args& a, LAS unsigned char* lds, int l, int s) {
    const int tid = ltid(), lane = tid & 63, wave = tid >> 6, c = tid;
    LAS float* red = (LAS float*)lds;
    const float* st = a.in[4] + (size_t)((l * MS + s) * 30) * CC + c; float* so = a.out + OUT_CONF_S + (size_t)((l * MS + s) * 30) * CC + c;
    float y = a.in[12][l * CC + c];
    float xs[30];
#pragma unroll
    for (int j = 0; j < 30; ++j) xs[j] = __builtin_nontemporal_load(st + (size_t)j * CC);
#pragma unroll
    for (int j = 0; j < 30; ++j) { y += a.in[11][(size_t)(l * KW + j) * CC + c] * xs[j]; if (j >= 1) __builtin_nontemporal_store(xs[j], so + (size_t)(j - 1) * CC); }
    const float un = bf2f(((const bf16*)(a.ws + WS_U))[(size_t)(MP + s) * CC + c]);
    y += a.in[11][(size_t)(l * KW + 30) * CC + c] * un; so[(size_t)29 * CC] = un;
    const float sv = wave_sum(y), qv = wave_sum(y * y);
    if (lane == 0) { red[wave * 2] = sv; red[wave * 2 + 1] = qv; }
    LBAR();
    float S = 0.f, Q = 0.f;
#pragma unroll
    for (int ww = 0; ww < 8; ++ww) { S += red[ww * 2]; Q += red[ww * 2 + 1]; }
    const float mu = S * (1.f / CC), var = fmaxf(Q * (1.f / CC) - mu * mu, 0.f), rstd = rsqrtf(var + 1e-5f);
    const float o = silu((y - mu) * rstd * a.in[13][l * CC + c] + a.in[14][l * CC + c]);
    ((bf16*)(a.ws + WS_CA))[(size_t)(MP + s) * CC + c] = (bf16)f2bf(o);
    LBAR();
}
__device__ __forceinline__ void delta_local_load(const Args& a, int it, u32x4 (&xr)[11]) {
    const int tid = ltid(); if (tid >= 384) return;
    const int b = it >> 7, h = (it >> 5) & 3, n = it & 31, m0 = b * TT + 64 * n;
    const int cgp = tid % 48, tg = tid / 48, part = cgp >> 4, c8 = cgp & 15, gcol = part * 512 + 128 * h + 8 * c8;
    const bf16* QKV = (const bf16*)(a.ws + WS_QKV);
#pragma unroll
    for (int r = 0; r < 11; ++r) { const int t = 8 * tg - 3 + r; xr[r] = (u32x4){0u, 0u, 0u, 0u};
        if (t >= 0 || n > 0) xr[r] = *(const u32x4*)(QKV + (size_t)(m0 + t) * QKVD + gcol); }
}
__device__ __forceinline__ void delta_local_item(const Args& a, LAS unsigned char* lds, int l, int b, int h, int n, u32x4 (&xr)[11], int it_next) {
    const int tid = ltid(), lane = tid & 63, wave = tid >> 6;
    constexpr int FS = 144, AS = 80;
    LAS float* Ff = (LAS float*)lds;
    LAS bf16* Qb = (LAS bf16*)(lds + 110592);
    LAS bf16* Kb = (LAS bf16*)(lds + 128000);
    LAS float* AMt = (LAS float*)lds;
    LAS float* AIt = (LAS float*)(lds + 20480);
    LAS float* gc = (LAS float*)(lds + 145408);
    LAS float* bt = gc + 64;
    LAS float* rn = bt + 64;
    const bf16* QKV = (const bf16*)(a.ws + WS_QKV); const float* BG = (const float*)(a.ws + WS_BG);
    const int m0 = b * TT + 64 * n, ci = (b * 4 + h) * 32 + n;
    if (tid < 384) { const int cgp = tid % 48, tg = tid / 48, part = cgp >> 4, c8 = cgp & 15, gcol = part * 512 + 128 * h + 8 * c8;
        const float* cw = a.in[16] + (size_t)l * 4 * QKVD + gcol;
        float w[4][8];
#pragma unroll
        for (int j = 0; j < 4; ++j) { const f32x4 w0 = *(const f32x4*)(cw + j * QKVD), w1 = *(const f32x4*)(cw + j * QKVD + 4);
#pragma unroll
            for (int e = 0; e < 4; ++e) { w[j][e] = w0[e]; w[j][4 + e] = w1[e]; } }
        LAS float* dst = Ff + (part * 64 + 8 * tg) * FS + 8 * c8;
#pragma unroll
        for (int tt = 0; tt < 8; ++tt) { float y[8];
#pragma unroll
            for (int e = 0; e < 8; ++e) { float s = 0.f;
#pragma unroll
                for (int j = 0; j < 4; ++j) { const unsigned xw = xr[tt + j][e >> 1]; const float xf = (e & 1) ? __uint_as_float(xw & 0xffff0000u) : __uint_as_float(xw << 16); s += w[j][e] * xf; }
                y[e] = silu(s); }
            *(LAS f32x4*)(dst + tt * FS) = (f32x4){y[0], y[1], y[2], y[3]}; *(LAS f32x4*)(dst + tt * FS + 4) = (f32x4){y[4], y[5], y[6], y[7]}; }
        if (n == 31 && tg == 7) { float* o = a.out + OUT_SHORT_P + (size_t)((l * 8 + b) * 3) * QKVD + gcol;
#pragma unroll
            for (int r = 0; r < 3; ++r) { const u32x4 x = xr[8 + r];
                *(f32x4*)(o + r * QKVD) = (f32x4){__uint_as_float(x[0] << 16), __uint_as_float(x[0] & 0xffff0000u), __uint_as_float(x[1] << 16), __uint_as_float(x[1] & 0xffff0000u)};
                *(f32x4*)(o + r * QKVD + 4) = (f32x4){__uint_as_float(x[2] << 16), __uint_as_float(x[2] & 0xffff0000u), __uint_as_float(x[3] << 16), __uint_as_float(x[3] & 0xffff0000u)}; } }
        if (it_next >= 0) delta_local_load(a, it_next, xr);
    } else if (tid >= 448) { float g = BG[(size_t)(m0 + lane) * 8 + 4 + h];
#pragma unroll
        for (int o = 1; o < 64; o <<= 1) { const float v = __shfl_up(g, o); if (lane >= o) g += v; }
        gc[lane] = g; bt[lane] = BG[(size_t)(m0 + lane) * 8 + h]; }
    LBAR();
    { const int t = tid >> 3, cs = tid & 7;
        f32x4 q4[4], k4[4]; float sq = 0.f, sk = 0.f;
#pragma unroll
        for (int c4 = 0; c4 < 4; ++c4) { const int cc = cs * 16 + c4 * 4; q4[c4] = *(LAS f32x4*)(Ff + t * FS + cc); k4[c4] = *(LAS f32x4*)(Ff + (64 + t) * FS + cc);
            sq += (q4[c4][0] * q4[c4][0] + q4[c4][1] * q4[c4][1]) + (q4[c4][2] * q4[c4][2] + q4[c4][3] * q4[c4][3]);
            sk += (k4[c4][0] * k4[c4][0] + k4[c4][1] * k4[c4][1]) + (k4[c4][2] * k4[c4][2] + k4[c4][3] * k4[c4][3]); }
        sq = oct_sum(sq); sk = oct_sum(sk);
        const float rq = rsqrtf(sq + 1e-6f) * 0.08838834764831845f, rk = rsqrtf(sk + 1e-6f), eg = __expf(gc[t]);
        bf16* qg = (bf16*)(a.ws + WS_DQG) + (size_t)ci * 8192 + t * 128 + cs * 16;
#pragma unroll
        for (int c4 = 0; c4 < 4; ++c4) { const int cc = cs * 16 + c4 * 4;
            f32x4 q = q4[c4] * rq; const f32x4 k = k4[c4] * rk;
            *(LAS f32x4*)(Ff + (64 + t) * FS + cc) = k;
            u32x2 qb; qb.x = pk2(q[0], q[1]); qb.y = pk2(q[2], q[3]); *(LAS u32x2*)(Qb + t * 136 + cc) = qb;
            u32x2 kb; kb.x = pk2(k[0], k[1]); kb.y = pk2(k[2], k[3]); *(LAS u32x2*)(Kb + t * 136 + cc) = kb;
            q = q * eg; u32x2 qo; qo.x = pk2(q[0], q[1]); qo.y = pk2(q[2], q[3]); *(u32x2*)(qg + c4 * 4) = qo; } }
    LBAR();
    { const int k = tid >> 2, tq = tid & 3; const float gl = gc[63]; unsigned o[8];
#pragma unroll
        for (int j = 0; j < 8; ++j) { const int t0 = 16 * tq + 2 * j;
            o[j] = pk2(Ff[(64 + t0) * FS + k] * __expf(gl - gc[t0]), Ff[(64 + t0 + 1) * FS + k] * __expf(gl - gc[t0 + 1])); }
        bf16* dst = (bf16*)(a.ws + WS_DKDT) + (size_t)ci * 8192 + k * 64 + 16 * tq;
        *(u32x4*)dst = (u32x4){o[0], o[1], o[2], o[3]}; *(u32x4*)(dst + 8) = (u32x4){o[4], o[5], o[6], o[7]};
        if (tid == 0) ((float*)(a.ws + WS_EGL))[ci] = __expf(gl); }
    { const int fr = lane & 15, fq = lane >> 4, ti = wave & 3; const bool isq = wave >= 4;
        const LAS bf16* Ab = (isq ? Qb : Kb) + (16 * ti + fr) * 136 + 8 * fq;
        bf16x8 af[4];
#pragma unroll
        for (int ks = 0; ks < 4; ++ks) af[ks] = *(const LAS bf16x8*)(Ab + 32 * ks);
        bf16* qkd = (bf16*)(a.ws + WS_DQKD) + (size_t)ci * 4096;
#pragma unroll
        for (int tj = 0; tj < 4; ++tj) { f32x4 acc = (f32x4){0.f, 0.f, 0.f, 0.f};
#pragma unroll
            for (int ks = 0; ks < 4; ++ks) { const bf16x8 bfr = *(const LAS bf16x8*)(Kb + (16 * tj + fr) * 136 + 32 * ks + 8 * fq); acc = __builtin_amdgcn_mfma_f32_16x16x32_bf16(af[ks], bfr, acc, 0, 0, 0); }
            const int j = 16 * tj + fr; const float gj = gc[j];
            f32x4 am;
#pragma unroll
            for (int e = 0; e < 4; ++e) { const int i = 16 * ti + 4 * fq + e; const float dec = __expf(fminf(gc[i] - gj, 0.f));
                if (isq) qkd[i * 64 + j] = (bf16)f2bf(j <= i ? acc[e] * dec : 0.f);
                am[e] = (j < i) ? bt[i] * acc[e] * dec : 0.f; }
            if (!isq) *(LAS f32x4*)(AMt + j * AS + 16 * ti + 4 * fq) = am; }
        if (!isq && lane < 16) { const int c = lane, i0 = 16 * ti; float r[16];
#pragma unroll
            for (int ii = 0; ii < 16; ++ii) r[ii] = (ii == c) ? 1.f : 0.f;
#pragma unroll
            for (int jj = 0; jj < 15; ++jj) {
#pragma unroll
                for (int ii = jj + 1; ii < 16; ++ii) r[ii] -= AMt[(i0 + jj) * AS + i0 + ii] * r[jj]; }
            LAS float* o = AIt + ti * 256 + c * 16;
#pragma unroll
            for (int q = 0; q < 4; ++q) *(LAS f32x4*)(o + 4 * q) = (f32x4){r[4 * q], r[4 * q + 1], r[4 * q + 2], r[4 * q + 3]}; } }
    LBAR();
    { const int fr = lane & 15, fq = lane >> 4; const bool isw = wave >= 4;
        LAS float* Fx = Ff + (isw ? 64 : 128) * FS + 32 * (wave & 3) + fr;
        float* du = (float*)(a.ws + WS_DU) + (size_t)ci * 8192 + 32 * (wave & 3) + fr; bf16* dw = (bf16*)(a.ws + WS_DW) + (size_t)ci * 8192 + 32 * (wave & 3) + fr;
#pragma unroll
        for (int i = 0; i < 4; ++i) { const int i0 = 16 * i;
            f32x4 acc[2];
#pragma unroll
            for (int e = 0; e < 4; ++e) { const int row = i0 + 4 * fq + e; float sc = bt[row]; if (isw) sc *= __expf(gc[row]);
                acc[0][e] = Fx[row * FS] * sc; acc[1][e] = Fx[row * FS + 16] * sc; }
#pragma unroll
            for (int j = 0; j < i; ++j)
#pragma unroll
                for (int s = 0; s < 4; ++s) { const int kk = 16 * j + 4 * s + fq; const float av = -AMt[kk * AS + i0 + fr];
                    acc[0] = __builtin_amdgcn_mfma_f32_16x16x4f32(av, Fx[kk * FS], acc[0], 0, 0, 0);
                    acc[1] = __builtin_amdgcn_mfma_f32_16x16x4f32(av, Fx[kk * FS + 16], acc[1], 0, 0, 0); }
#pragma unroll
            for (int e = 0; e < 4; ++e) { const int row = i0 + 4 * fq + e; Fx[row * FS] = acc[0][e]; Fx[row * FS + 16] = acc[1][e]; }
            f32x4 x[2] = {(f32x4){0.f, 0.f, 0.f, 0.f}, (f32x4){0.f, 0.f, 0.f, 0.f}};
#pragma unroll
            for (int s = 0; s < 4; ++s) { const int kk = 4 * s + fq; const float av = AIt[i * 256 + kk * 16 + fr];
                x[0] = __builtin_amdgcn_mfma_f32_16x16x4f32(av, Fx[(i0 + kk) * FS], x[0], 0, 0, 0);
                x[1] = __builtin_amdgcn_mfma_f32_16x16x4f32(av, Fx[(i0 + kk) * FS + 16], x[1], 0, 0, 0); }
#pragma unroll
            for (int e = 0; e < 4; ++e) { const int row = i0 + 4 * fq + e; Fx[row * FS] = x[0][e]; Fx[row * FS + 16] = x[1][e];
                if (isw) { dw[row * 128] = (bf16)f2bf(x[0][e]); dw[row * 128 + 16] = (bf16)f2bf(x[1][e]); }
                else { du[row * 128] = x[0][e]; du[row * 128 + 16] = x[1][e]; } } } }
    LBAR();
}
__device__ __forceinline__ void phase_c1(const Args& a, LAS unsigned char* lds, int l) {
#ifndef C1REP_D
#define C1REP_D 1
#endif
#ifndef C1REP_C
#define C1REP_C 1
#endif
    for (int rr = 0; rr < C1REP_D; ++rr)
    { u32x4 xr[11]; int it = lbid(); const int G = (int)gridDim.x;
#pragma unroll
      for (int r = 0; r < 11; ++r) xr[r] = (u32x4){0u, 0u, 0u, 0u};
      if (it < 1024) delta_local_load(a, it, xr);
#pragma unroll 1
      for (; it < 1024; it += G) delta_local_item(a, lds, l, it >> 7, (it >> 5) & 3, it & 31, xr, it + G < 1024 ? it + G : -1); }
}
__device__ __forceinline__ void conv_items(const Args& a, LAS unsigned char* lds, int l, int ob, int OG, bool with_sample) {
    for (int it = ob; it < 256 + (with_sample ? 128 : 0); it += OG) {
        if (it < 256) conv_prompt_item(a, lds, l, it >> 5, it & 31);
        else conv_sample_item(a, lds, l, it - 256);
    }
}

template <int NT, int MODE = 0>
__device__ __forceinline__ void delta_seq_item(const Args& a, LAS unsigned char* lds, int l, int it) {
    const int tid = ltid(), lane = tid & 63, w = tid >> 6, fr = lane & 15, fq = lane >> 4, rb = w & 3;
    constexpr int NVS = 8 / NT, VW = 16 * NT; const int bh = it / NVS, vs = it % NVS, b = bh >> 2, h = bh & 3;
    LAS bf16* St = (LAS bf16*)lds;
    LAS bf16* VNt = St + VW * 136;
    for (int i = tid; i < VW * 136 / 2; i += 512) ((LAS unsigned*)St)[i] = 0u;
    LBAR();
    const bf16* DW = (const bf16*)(a.ws + WS_DW); const bf16* DQG = (const bf16*)(a.ws + WS_DQG); const bf16* DKDT = (const bf16*)(a.ws + WS_DKDT);
    const bf16* DQKD = (const bf16*)(a.ws + WS_DQKD); const float* DU = (const float*)(a.ws + WS_DU); const float* EGL = (const float*)(a.ws + WS_EGL);
    float* O = (float*)(a.ws + WS_O);
    f32x4 Sacc[NT];
#pragma unroll
    for (int t = 0; t < NT; ++t) Sacc[t] = (f32x4){0.f, 0.f, 0.f, 0.f};
    const bool lead = w < 4;
#define WGBAR() do { if (MODE != 1) { asm volatile("s_waitcnt lgkmcnt(0)" ::: "memory"); __builtin_amdgcn_s_barrier(); asm volatile("" ::: "memory"); } } while (0)
    int vz = 0; asm volatile("" : "+v"(vz));
    struct ChunkOps { bf16x8 af[4], kd[2], qd[2]; float uu[NT][4], egl; };
#define D1_LOAD(B, n_) do { if (MODE == 2 && (n_) >= 4) break; const size_t ci_ = (size_t)bh * 32 + ((n_) < 32 ? (n_) : 31); \
        const bf16* Aop_ = (lead ? DW : DQG) + ci_ * 8192 + (16 * rb + fr) * 128 + 8 * fq; \
        _Pragma("unroll") for (int ks = 0; ks < 4; ++ks) B.af[ks] = *(const bf16x8*)(Aop_ + 32 * ks); \
        _Pragma("unroll") for (int k2 = 0; k2 < 2; ++k2) B.kd[k2] = *(const bf16x8*)(DKDT + ci_ * 8192 + (16 * w + fr) * 64 + 32 * k2 + 8 * fq); \
        if (lead) { _Pragma("unroll") for (int t = 0; t < NT; ++t) _Pragma("unroll") for (int e = 0; e < 4; ++e) B.uu[t][e] = DU[ci_ * 8192 + (16 * rb + 4 * fq + e) * 128 + VW * vs + 16 * t + fr]; } \
        else { _Pragma("unroll") for (int k2 = 0; k2 < 2; ++k2) B.qd[k2] = *(const bf16x8*)(DQKD + ci_ * 4096 + (16 * rb + fr) * 64 + 32 * k2 + 8 * fq); } \
        B.egl = EGL[ci_ + vz]; } while (0)
#define D1_INIT(B) do { _Pragma("unroll") for (int t = 0; t < NT; ++t) _Pragma("unroll") for (int e = 0; e < 4; ++e) B.uu[t][e] = 0.f; B.qd[0] = B.qd[1] = (bf16x8){0, 0, 0, 0, 0, 0, 0, 0}; } while (0)
#define D1_STEP(B, n_) do { \
        f32x4 acc[NT]; _Pragma("unroll") for (int t = 0; t < NT; ++t) acc[t] = (f32x4){0.f, 0.f, 0.f, 0.f}; \
        _Pragma("unroll") for (int ks = 0; ks < 4; ++ks) _Pragma("unroll") for (int t = 0; t < NT; ++t) { \
            const bf16x8 bfr = *(const LAS bf16x8*)(St + (16 * t + fr) * 136 + 32 * ks + 8 * fq); acc[t] = __builtin_amdgcn_mfma_f32_16x16x32_bf16(B.af[ks], bfr, acc[t], 0, 0, 0); } \
        if (lead) { _Pragma("unroll") for (int t = 0; t < NT; ++t) { u32x2 o; o.x = pk2(B.uu[t][0] - acc[t][0], B.uu[t][1] - acc[t][1]); o.y = pk2(B.uu[t][2] - acc[t][2], B.uu[t][3] - acc[t][3]); \
            *(LAS u32x2*)(VNt + (16 * t + fr) * 72 + 16 * rb + 4 * fq) = o; } } \
        WGBAR(); \
        bf16x8 bv[NT][2]; \
        _Pragma("unroll") for (int t = 0; t < NT; ++t) _Pragma("unroll") for (int k2 = 0; k2 < 2; ++k2) bv[t][k2] = *(const LAS bf16x8*)(VNt + (16 * t + fr) * 72 + 32 * k2 + 8 * fq); \
        if (!lead) { \
            _Pragma("unroll") for (int t = 0; t < NT; ++t) { \
                _Pragma("unroll") for (int k2 = 0; k2 < 2; ++k2) acc[t] = __builtin_amdgcn_mfma_f32_16x16x32_bf16(B.qd[k2], bv[t][k2], acc[t], 0, 0, 0); \
                float* op = O + (size_t)(b * TT + 64 * (n_) + 16 * rb + 4 * fq) * CC + 128 * h + VW * vs + 16 * t + fr; \
                _Pragma("unroll") for (int e = 0; e < 4; ++e) op[(size_t)e * CC] = acc[t][e]; } \
        } \
        _Pragma("unroll") for (int t = 0; t < NT; ++t) { Sacc[t] = Sacc[t] * B.egl; \
            _Pragma("unroll") for (int k2 = 0; k2 < 2; ++k2) Sacc[t] = __builtin_amdgcn_mfma_f32_16x16x32_bf16(B.kd[k2], bv[t][k2], Sacc[t], 0, 0, 0); \
            u32x2 o; o.x = pk2(Sacc[t][0], Sacc[t][1]); o.y = pk2(Sacc[t][2], Sacc[t][3]); *(LAS u32x2*)(St + (16 * t + fr) * 136 + 16 * w + 4 * fq) = o; } \
        WGBAR(); } while (0)
    ChunkOps B0, B1, B2, B3;
    D1_INIT(B0); D1_INIT(B1); D1_INIT(B2); D1_INIT(B3);
    D1_LOAD(B0, 0); D1_LOAD(B1, 1); D1_LOAD(B2, 2); D1_LOAD(B3, 3);
#pragma unroll 1
    for (int n = 0; n < 32; n += 4) {
        D1_STEP(B0, n);     D1_LOAD(B0, n + 4);
        D1_STEP(B1, n + 1); D1_LOAD(B1, n + 5);
        D1_STEP(B2, n + 2); D1_LOAD(B2, n + 6);
        D1_STEP(B3, n + 3); D1_LOAD(B3, n + 7);
    }
#undef D1_LOAD
#undef D1_INIT
#undef D1_STEP
#pragma unroll
    for (int t = 0; t < NT; ++t) { float* so = a.out + OUT_DELTA_P + ((size_t)((l * 8 + b) * 4 + h) * 128 + 16 * w + 4 * fq) * 128 + VW * vs + 16 * t + fr;
#pragma unroll
        for (int e = 0; e < 4; ++e) so[(size_t)e * 128] = Sacc[t][e]; }
    LBAR();
}
__device__ __forceinline__ void delta_sample_item(const Args& a, LAS unsigned char* lds, int l, int s, int h) {
    const int tid = ltid(), lane = tid & 63, wave = tid >> 6;
    LAS float* qkv = (LAS float*)lds;
    LAS float* misc = qkv + 384;
    LAS float* vnew = misc + 16;
    LAS float* PK = vnew + 128;
    LAS float* PQ = PK + 2048;
    const int kg = tid >> 5, c4 = tid & 31;
    const size_t sbase = ((size_t)((l * MS + s) * 4 + h) * 128) * 128;
    const float* Sin = a.in[6] + sbase;
    f32x4 Sr[8];
#pragma unroll
    for (int r = 0; r < 8; ++r) Sr[r] = __builtin_nontemporal_load((const f32x4*)(Sin + (size_t)(kg * 8 + r) * 128 + 4 * c4));
    if (tid < 384) { const int part = tid >> 7, col = tid & 127, gcol = part * 512 + 128 * h + col;
        const float* cw = a.in[16] + (size_t)l * 4 * QKVD + gcol; const float* st = a.in[5] + (size_t)((l * MS + s) * 3) * QKVD + gcol;
        const float x0 = st[0], x1 = st[QKVD], x2 = st[2 * QKVD], x3 = bf2f(((const bf16*)(a.ws + WS_QKV))[(size_t)(MP + s) * QKVD + gcol]);
        qkv[tid] = silu(cw[0] * x0 + cw[QKVD] * x1 + cw[2 * QKVD] * x2 + cw[3 * QKVD] * x3);
        float* o = a.out + OUT_SHORT_S + (size_t)((l * MS + s) * 3) * QKVD + gcol; o[0] = x1; o[QKVD] = x2; o[2 * QKVD] = x3; }
    LBAR();
    float rq, rk, qk;
    { const float q0 = qkv[lane], q1 = qkv[lane + 64], k0 = qkv[128 + lane], k1 = qkv[192 + lane];
        const float qq = wave_sum(q0 * q0 + q1 * q1), kk = wave_sum(k0 * k0 + k1 * k1), qkr = wave_sum(q0 * k0 + q1 * k1);
        rq = rsqrtf(qq + 1e-6f) * 0.08838834764831845f; rk = rsqrtf(kk + 1e-6f); qk = qkr * rq * rk; }
    const float* BG = (const float*)(a.ws + WS_BG);
    const float beta = BG[(size_t)(MP + s) * 8 + h], eg = __expf(BG[(size_t)(MP + s) * 8 + 4 + h]);
    f32x4 pk = (f32x4){0.f, 0.f, 0.f, 0.f}, pq = pk;
#pragma unroll
    for (int r = 0; r < 8; ++r) { const float kv = qkv[128 + kg * 8 + r] * rk, qv = qkv[kg * 8 + r] * rq; pk += Sr[r] * kv; pq += Sr[r] * qv; }
    *(LAS f32x4*)(PK + kg * 128 + 4 * c4) = pk; *(LAS f32x4*)(PQ + kg * 128 + 4 * c4) = pq;
    LBAR();
    if (tid < 128) { float kS = 0.f, qS = 0.f;
#pragma unroll
        for (int g = 0; g < 16; ++g) { kS += PK[g * 128 + tid]; qS += PQ[g * 128 + tid]; }
        const float vn = beta * (qkv[256 + tid] - eg * kS);
        ((float*)(a.ws + WS_O))[(size_t)(MP + s) * CC + 128 * h + tid] = eg * qS + qk * vn;
        vnew[tid] = vn; }
    LBAR();
    const f32x4 vn4 = *(const LAS f32x4*)(vnew + 4 * c4);
    float* So = a.out + OUT_DELTA_S + sbase;
#pragma unroll
    for (int r = 0; r < 8; ++r) { const float kv = qkv[128 + kg * 8 + r] * rk; __builtin_nontemporal_store(Sr[r] * eg + vn4 * kv, (f32x4*)(So + (size_t)(kg * 8 + r) * 128 + 4 * c4)); }
    LBAR();
}
__device__ __forceinline__ void phase_e1(const Args& a, int l) {
    const int tid = ltid(), lane = tid & 63, wave = tid >> 6;
    const int gw = lbid() * 8 + wave, NGW = gridDim.x * 8;
    const float* O = (const float*)(a.ws + WS_O); const bf16* ZS = (const bf16*)(a.ws + WS_ZS); bf16* OB = (bf16*)(a.ws + WS_OB);
    const float* gn = a.in[19] + l * HD + 8 * (lane & 15);
    const f32x4 g0 = *(const f32x4*)gn, g1 = *(const f32x4*)(gn + 4);
    f32x4 p0[2], p1[2]; u32x4 pz[2];
#pragma unroll
    for (int q = 0; q < 2; ++q) { const int mm = gw + q * NGW;
        if (mm < MV) { p0[q] = *(const f32x4*)(O + (size_t)mm * CC + 8 * lane); p1[q] = *(const f32x4*)(O + (size_t)mm * CC + 8 * lane + 4); pz[q] = *(const u32x4*)(ZS + (size_t)mm * CC + 8 * lane); } }
    for (int m = gw; m < MV; m += NGW) {
        const f32x4 o0 = p0[0], o1 = p1[0]; const u32x4 z = pz[0];
        p0[0] = p0[1]; p1[0] = p1[1]; pz[0] = pz[1];
        { const int mm = m + 2 * NGW; if (mm < MV) { p0[1] = *(const f32x4*)(O + (size_t)mm * CC + 8 * lane); p1[1] = *(const f32x4*)(O + (size_t)mm * CC + 8 * lane + 4); pz[1] = *(const u32x4*)(ZS + (size_t)mm * CC + 8 * lane); } }
        float ss = (o0[0] * o0[0] + o0[1] * o0[1]) + (o0[2] * o0[2] + o0[3] * o0[3]) + (o1[0] * o1[0] + o1[1] * o1[1]) + (o1[2] * o1[2] + o1[3] * o1[3]);
        ss = row16_sum(ss);
        const float r = rsqrtf(ss * (1.f / HD) + 1e-6f);
        float v[8];
#pragma unroll
        for (int j = 0; j < 8; ++j) { const unsigned zw = z[j >> 1]; const float zf = (j & 1) ? __uint_as_float(zw & 0xffff0000u) : __uint_as_float(zw << 16);
            v[j] = (j < 4 ? o0[j] * g0[j] : o1[j - 4] * g1[j - 4]) * r * zf; }
        u32x4 w; w.x = pk2(v[0], v[1]); w.y = pk2(v[2], v[3]); w.z = pk2(v[4], v[5]); w.w = pk2(v[6], v[7]);
        *(u32x4*)(OB + (size_t)m * CC + 8 * lane) = w;
    }
}

__global__ void __launch_bounds__(512, 2) mega(Args a0) {
    extern __shared__ __attribute__((aligned(16))) unsigned char lds_raw[];
    LAS unsigned char* lds = (LAS unsigned char*)lds_raw;
    cg::grid_group grid = cg::this_grid();
    volatile LAS unsigned* bst = (volatile LAS unsigned*)(lds + LDS_BYTES - 64);
    if (threadIdx.x < 2) bst[threadIdx.x] = 0u;
    __syncthreads();
    XcdBarrier xbar = xcd_barrier_post((unsigned*)(a0.ws + 16384), bst);
    for (int ph = a0.ph_lo; ph < a0.ph_hi; ++ph) {
        size_t zoff = 0; asm volatile("" : "+s"(zoff));
        Args a = a0; a.ws = a0.ws + zoff; a.out = a0.out + zoff;
#ifndef REPMASK
#define REPMASK 0
#endif
        const int ptype = ph == 0 ? 10 : ph == 1 ? 11 : ph == NPH - 1 ? 12 : (ph - 2) % 10;
        const int nrep = 1 + ((REPMASK >> ptype) & 1);
        for (int rep = 0; rep < nrep; ++rep) {
        if (rep > 0) xcd_barrier(xbar);
#ifndef PHMASK
#define PHMASK 0xFFFF
#endif
#define HAS(x) ((PHMASK >> (x)) & 1)
        if (ph == 0) { if (HAS(10)) phase_p0a(a, lds); }
        else if (ph == 1) { if (HAS(11)) { EpiMod E{(float*)(a.ws + WS_MOD), a.in[8]}; run_gemm(lds, (const bf16*)(a.ws + WS_SC), (const bf16*)(a.ws + WS_WADA), 256, MODLD, 1024, E);
            { const int G = (int)gridDim.x, nu = MODLD / 256, bid = lbid();
              if (G > nu) { if (bid >= nu) convert_layer(a, lds, 0, (bid - nu) * 8 + (ltid() >> 6), (G - nu) * 8); }
              else convert_layer(a, lds, 0, bid * 8 + (ltid() >> 6), G * 8); } } }
        else if (ph == NPH - 1) { if (HAS(12)) phase_final(a); }
        else {
            const int l = (ph - 2) / 10, j = (ph - 2) % 10;
            unsigned char* lw = a.ws + WS_W + (size_t)l * LW_SZ;
            const float* MODl = (const float*)(a.ws + WS_MOD) + (size_t)l * NMOD;
            switch (j) {
            case 0: if (HAS(0)) phase_norm<0>(a, lds, l); break;
            case 1: if (HAS(1)) { EpiIn E{(bf16*)(a.ws + WS_U), (bf16*)(a.ws + WS_QKV), (bf16*)(a.ws + WS_ZS), (bf16*)(a.ws + WS_MA), (bf16*)(a.ws + WS_MB)};
                run_gemm(lds, (const bf16*)(a.ws + WS_H), (const bf16*)(lw + LW_IN), MP, NIN, 1024, E);
                { SkInAll E1{E.U, E.QKV, E.ZS, E.MA, E.MB}; splitk_units<2, 5>(lds, (const bf16*)(a.ws + WS_H) + (size_t)MP * 1024, (const bf16*)(lw + LW_IN), 1024, 64, E1); } } break;
            case 2: if (HAS(2)) phase_c1(a, lds, l); break;
            case 3: if (HAS(3)) {
                const int bidx = lbid(), G = (int)gridDim.x; int ob = bidx, OG = G; bool with_sample = (G != 256);
#ifndef D1_NT
#define D1_NT 2
#endif
                constexpr int NVS = 8 / D1_NT, NSB = 4 * NVS;
                if (G == 256) { const int x = bidx & 7, j = bidx >> 3;
#ifdef D1EXP
                    if (j < NSB) delta_seq_item<D1_NT, D1EXP>(a, lds, l, (4 * x + j / NVS) * NVS + (j % NVS));
#endif
                    if (j < NSB) { delta_seq_item<D1_NT>(a, lds, l, (4 * x + j / NVS) * NVS + (j % NVS)); ob = -1;
                        for (int s = x + 8 * j; s < 128; s += 8 * NSB) conv_sample_item(a, lds, l, s); with_sample = false; }
                    else { ob = x + 8 * (j - NSB); OG = 256 - 8 * NSB; } }
                else { for (int it = bidx; it < 32 * NVS; it += G) delta_seq_item<D1_NT>(a, lds, l, it); }
                if (ob >= 0) {
                    for (int it = ob; it < 512; it += OG) delta_sample_item(a, lds, l, it >> 2, it & 3);
                    conv_items(a, lds, l, ob, OG, with_sample);
                }
                } break;
            case 4: if (HAS(4)) phase_e1(a, l); break;
            case 5: if (HAS(5)) { EpiMerge E{(const bf16*)(a.ws + WS_MA), (const bf16*)(a.ws + WS_MB), (bf16*)(a.ws + WS_MG)};
                { pg8::Gemm g{(const bf16*)(a.ws + WS_OB), (const bf16*)(lw + LW_D), MP, D, 512, (long)WS_CA - (long)WS_OB, (long)LW_C - (long)LW_D};
                  pg8::TwoSegOrder S; S.init(MP, D, (int)gridDim.x, lbid()); pg8::gemm_phase<EpiMerge, pg8::TwoSegOrder, true, true>(lds, g, S, E); }
                { SkGate<false> E1{E.SA, nullptr, (bf16*)(a.ws + WS_Y)}; splitk_units<1, 2>(lds, (const bf16*)(a.ws + WS_CA) + (size_t)MP * 512, (const bf16*)(lw + LW_C), 512, 32, E1);
                  SkGate<true> E2{E.SB, (const bf16*)(a.ws + WS_Y), E.Out}; splitk_units<1, 2>(lds, (const bf16*)(a.ws + WS_OB) + (size_t)MP * 512, (const bf16*)(lw + LW_D), 512, 32, E2); } } break;
            case 6: if (HAS(6)) { EpiRes E{a.in[0], a.in[1], (const float*)(a.ws + WS_X), (float*)(a.ws + WS_X), MODl + 2 * D, l == 0 ? 1 : 0};
                run_gemm(lds, (const bf16*)(a.ws + WS_MG), (const bf16*)(lw + LW_M), MP, D, 1024, E);
                { SkRes E1{a.in[1], E.Xin, E.Xout, E.gt, E.use_in}; splitk_units<1, 2>(lds, (const bf16*)(a.ws + WS_MG) + (size_t)MP * 1024, (const bf16*)(lw + LW_M), 1024, 32, E1); } } break;
            case 7: if (HAS(7)) phase_norm<1>(a, lds, l); break;
            case 8: if (HAS(8)) { EpiSwi E{(bf16*)(a.ws + WS_HH)};
                run_gemm(lds, (const bf16*)(a.ws + WS_H), (const bf16*)(lw + LW_F1), MT, NF1, 1024, E);
                if (l + 1 < NL) {
                    const int G = (int)gridDim.x, nu = (MT / 256) * (NF1 / 256), first = (nu % G) ? (nu % G) : 0, nb = G - first, bid = lbid();
                    if (bid >= first) convert_layer(a, lds, l + 1, (bid - first) * 8 + (ltid() >> 6), nb * 8); } } break;
            default: if (HAS(9)) { EpiRes E{a.in[0], a.in[1], (const float*)(a.ws + WS_X), (float*)(a.ws + WS_X), MODl + 5 * D, 0};
                run_gemm(lds, (const bf16*)(a.ws + WS_HH), (const bf16*)(lw + LW_F2), MP, D, DFF, E);
                { SkRes E1{a.in[1], E.Xin, E.Xout, E.gt, 0}; splitk_units<1, 2, 6>(lds, (const bf16*)(a.ws + WS_HH) + (size_t)MP * DFF, (const bf16*)(lw + LW_F2), DFF, 32, E1); } } break;
            }
        }
        }
        if (ph + 1 < a0.ph_hi) { if (a0.ph_lo < 0) { __threadfence(); grid.sync(); }
            else { xcd_barrier(xbar);
#ifdef BARREP
            xcd_barrier(xbar);
#endif
        } }
    }
}

extern "C" void kernel_launch(void* const* d_in, const int* in_sizes, int n_in, void* d_out, int out_size, void* d_ws, size_t ws_size, hipStream_t stream) {
    static int grid = 0;
    if (grid == 0) {
        if (n_in != 26 || ws_size < WS_END || out_size != 63422464) { fprintf(stderr, "kernel_launch: unexpected problem: n_in %d ws %zu out %d\n", n_in, ws_size, out_size); grid = -1; return; }
        int dev = 0, cus = 0, per_cu = 0;
        if (hipGetDevice(&dev) != hipSuccess || hipDeviceGetAttribute(&cus, hipDeviceAttributeMultiprocessorCount, dev) != hipSuccess) { grid = -1; return; }
        if (hipFuncSetAttribute((const void*)mega, hipFuncAttributeMaxDynamicSharedMemorySize, LDS_BYTES) != hipSuccess) { fprintf(stderr, "kernel_launch: hipFuncSetAttribute failed\n"); grid = -1; return; }
        if (hipOccupancyMaxActiveBlocksPerMultiprocessor(&per_cu, (const void*)mega, 512, LDS_BYTES) != hipSuccess || per_cu < 1) { fprintf(stderr, "kernel_launch: occupancy query says %d\n", per_cu); per_cu = 1; }
        (void)hipGetLastError();
        grid = cus * (per_cu > 1 ? 1 : per_cu);
    }
    if (grid < 0) return;
    Args a{};
    for (int i = 0; i < 26; ++i) a.in[i] = (const float*)d_in[i];
    a.out = (float*)d_out; a.ws = (unsigned char*)d_ws;
#if MK_ONE_LAUNCH
    if (hipMemsetAsync(d_ws, 0, 65536, stream) != hipSuccess) { fprintf(stderr, "kernel_launch: memset failed\n"); return; }
    a.ph_lo = 0; a.ph_hi = NPH;
    void* args[] = {&a};
    hipError_t e = hipLaunchCooperativeKernel((const void*)mega, dim3(grid), dim3(512), args, LDS_BYTES, stream);
    if (e != hipSuccess) fprintf(stderr, "cooperative launch failed: %s (grid %d)\n", hipGetErrorString(e), grid);
#else
    for (int ph = 0; ph < NPH; ++ph) { a.ph_lo = ph; a.ph_hi = ph + 1; hipLaunchKernelGGL(mega, dim3(grid), dim3(512), LDS_BYTES, stream, a); }
#endif
}
```
